# Optimizing an MI355X kernel written in HIP

```python
import jax
import jax.numpy as jnp
from jax import lax
import numpy as np

D_MODEL = 2048
BATCH = 16
SEQ = 2048
DEPTH = 4

CHUNK = 64
N_MEM = 256
RMS_EPS = 1e-6
MAX_STREAM_CHUNKS = 1024

GMLP_BLOCK = 128
A_WIDTH = D_MODEL // 2
A_GROUPS = 8
A_GROUP_DIM = A_WIDTH // A_GROUPS

B_WIDTH = D_MODEL - A_WIDTH
B_GROUPS = 8
CONV_WIDTH = 3
AB_IN = 2 * A_WIDTH + 3 * B_WIDTH

C_HEADS = D_MODEL // 128
C_NOPE = 128
C_ROPE = 64
C_V = 128
C_Q_RANK = 512
C_KV_RANK = 256
C_IN = C_Q_RANK + C_KV_RANK + C_ROPE
ROPE_THETA = 10000.0
Q_BLOCK = 128

MEM_HEADS = 4
MEM_HEAD_DIM = D_MODEL // MEM_HEADS

D_FF = 4 * D_MODEL

N_EVEN = (DEPTH + 1) // 2
N_ODD = DEPTH // 2

kernel_name = 'hybrid_gmlp_shortconv_mla_memxattn_trunk'


def rmsnorm(x, g):
    xf = x.astype(jnp.float32)
    y = xf * lax.rsqrt(jnp.mean(xf * xf, axis=-1, keepdims=True) + RMS_EPS)
    return (y * g.astype(jnp.float32)).astype(x.dtype)


def gmlp_spatial_gate(u, v, v_norm_g, w_s, b_s):
    bsz, seq, _ = u.shape
    nb = seq // GMLP_BLOCK
    vg = v.reshape(bsz, seq, A_GROUPS, A_GROUP_DIM)
    vg = rmsnorm(vg, v_norm_g.reshape(A_GROUPS, A_GROUP_DIM))
    vg = vg.reshape(bsz, nb, GMLP_BLOCK, A_GROUPS, A_GROUP_DIM)
    cid = jnp.arange(GMLP_BLOCK) // CHUNK
    mask = (cid[None, :] <= cid[:, None]).astype(w_s.dtype)
    w = w_s * mask[None]
    mixed = jnp.einsum('gij,bnjgc->bnigc', w, vg) + b_s.T[None, None, :, :, None]
    return u * mixed.reshape(bsz, seq, A_WIDTH)


def gated_short_conv(bg, cg, h, conv_w):
    z = cg * h
    seq = z.shape[1]
    zp = jnp.pad(z, ((0, 0), (CONV_WIDTH - 1, 0), (0, 0)))
    conv = sum(conv_w[k] * zp[:, k:k + seq] for k in range(CONV_WIDTH))
    return bg * conv


def mixer_gmlp_conv(xn, w_in, v_norm_g, w_s, b_s, conv_w, w_out):
    z = xn @ w_in
    u, v, bg, cg, h = jnp.split(
        z, [A_WIDTH, 2 * A_WIDTH, 2 * A_WIDTH + B_WIDTH, 2 * A_WIDTH + 2 * B_WIDTH], axis=-1)
    y_a = gmlp_spatial_gate(jax.nn.gelu(u), jax.nn.gelu(v), v_norm_g, w_s, b_s)
    y_b = gated_short_conv(bg, cg, h, conv_w)
    return jnp.concatenate([y_a, y_b], axis=-1) @ w_out


def rope_tables(positions):
    inv = ROPE_THETA ** (-jnp.arange(0, C_ROPE, 2, dtype=jnp.float32) / C_ROPE)
    ang = positions.astype(jnp.float32)[..., None] * inv
    return jnp.cos(ang), jnp.sin(ang)


def apply_rope(x, cos, sin):
    half = x.shape[-1] // 2
    x1 = x[..., :half].astype(jnp.float32)
    x2 = x[..., half:].astype(jnp.float32)
    return jnp.concatenate([x1 * cos - x2 * sin, x2 * cos + x1 * sin], axis=-1).astype(x.dtype)


def mixer_mla(xn, positions, w_in, q_norm_g, kv_norm_g, w_uq, w_ukv, w_out):
    bsz, seq, _ = xn.shape
    z = xn @ w_in
    c_q, c_kv, k_rope = jnp.split(z, [C_Q_RANK, C_Q_RANK + C_KV_RANK], axis=-1)
    q = (rmsnorm(c_q, q_norm_g) @ w_uq).reshape(bsz, seq, C_HEADS, C_NOPE + C_ROPE)
    kv = (rmsnorm(c_kv, kv_norm_g) @ w_ukv).reshape(bsz, seq, C_HEADS, C_NOPE + C_V)
    cos, sin = rope_tables(positions)
    q_nope = q[..., :C_NOPE]
    q_rope = apply_rope(q[..., C_NOPE:], cos[:, :, None], sin[:, :, None])
    k_nope = kv[..., :C_NOPE]
    v = kv[..., C_NOPE:]
    k_rope = apply_rope(k_rope, cos, sin)
    scale = (C_NOPE + C_ROPE) ** -0.5
    chunk_id = jnp.arange(seq) // CHUNK
    outs = []
    for qb in range(seq // Q_BLOCK):
        q0, q1 = qb * Q_BLOCK, (qb + 1) * Q_BLOCK
        s = (jnp.einsum('bqhd,bkhd->bhqk', q_nope[:, q0:q1], k_nope[:, :q1])
             + jnp.einsum('bqhr,bkr->bhqk', q_rope[:, q0:q1], k_rope[:, :q1]))
        s = s.astype(jnp.float32) * scale
        mask = chunk_id[None, :q1] <= chunk_id[q0:q1, None]
        s = jnp.where(mask[None, None], s, -jnp.inf)
        p = jax.nn.softmax(s, axis=-1).astype(v.dtype)
        outs.append(jnp.einsum('bhqk,bkhd->bqhd', p, v[:, :q1]))
    o = jnp.concatenate(outs, axis=1).reshape(bsz, seq, C_HEADS * C_V)
    return o @ w_out


def mem_cross_attention(xn, memn, wq, wk, wv, wo):
    bsz, seq, _ = xn.shape
    n_mem = memn.shape[1]
    q = (xn @ wq).reshape(bsz, seq, MEM_HEADS, MEM_HEAD_DIM)
    k = (memn @ wk).reshape(bsz, n_mem, MEM_HEADS, MEM_HEAD_DIM)
    v = (memn @ wv).reshape(bsz, n_mem, MEM_HEADS, MEM_HEAD_DIM)
    s = jnp.einsum('bqhd,bmhd->bhqm', q, k).astype(jnp.float32) * (MEM_HEAD_DIM ** -0.5)
    p = jax.nn.softmax(s, axis=-1).astype(v.dtype)
    o = jnp.einsum('bhqm,bmhd->bqhd', p, v).reshape(bsz, seq, D_MODEL)
    return o @ wo


def squared_relu_mlp(xn, w1, w2):
    h = jax.nn.relu(xn @ w1)
    return (h * h) @ w2


def _normal(key, shape, scale):
    return jax.random.normal(key, shape, jnp.float32) * scale


def _gain(key, shape):
    return 1.0 + 0.02 * jax.random.normal(key, shape, jnp.float32)


def setup_inputs(seed: int = 0) -> dict:
    key = jax.random.key(seed)
    ks = jax.random.split(key, 26)
    d = D_MODEL
    offset = jax.random.randint(ks[2], (BATCH, 1), 0, MAX_STREAM_CHUNKS, dtype=jnp.int32) * CHUNK
    positions = offset + jnp.arange(SEQ, dtype=jnp.int32)[None, :]
    return {
        'x': _normal(ks[0], (BATCH, SEQ, d), 1.0),
        'mem': _normal(ks[1], (BATCH, N_MEM, d), 1.0),
        'positions': positions,
        'norm_mix_g': _gain(ks[3], (DEPTH, d)),
        'norm_mem_q_g': _gain(ks[4], (DEPTH, d)),
        'norm_mem_kv_g': _gain(ks[5], (DEPTH, d)),
        'norm_ffn_g': _gain(ks[6], (DEPTH, d)),
        'final_norm_g': _gain(ks[7], (d,)),
        'ab_w_in': _normal(ks[8], (N_EVEN, d, AB_IN), d ** -0.5),
        'a_v_norm_g': _gain(ks[9], (N_EVEN, A_WIDTH)),
        'a_w_s': _normal(ks[10], (N_EVEN, A_GROUPS, GMLP_BLOCK, GMLP_BLOCK), GMLP_BLOCK ** -0.5),
        'a_b_s': _gain(ks[11], (N_EVEN, A_GROUPS, GMLP_BLOCK)),
        'b_conv_w': _normal(ks[12], (N_EVEN, CONV_WIDTH, B_WIDTH), CONV_WIDTH ** -0.5),
        'ab_w_out': _normal(ks[13], (N_EVEN, A_WIDTH + B_WIDTH, d), (A_WIDTH + B_WIDTH) ** -0.5),
        'c_w_in': _normal(ks[14], (N_ODD, d, C_IN), d ** -0.5),
        'c_q_norm_g': _gain(ks[15], (N_ODD, C_Q_RANK)),
        'c_kv_norm_g': _gain(ks[16], (N_ODD, C_KV_RANK)),
        'c_w_uq': _normal(ks[17], (N_ODD, C_Q_RANK, C_HEADS * (C_NOPE + C_ROPE)), C_Q_RANK ** -0.5),
        'c_w_ukv': _normal(ks[18], (N_ODD, C_KV_RANK, C_HEADS * (C_NOPE + C_V)), C_KV_RANK ** -0.5),
        'c_w_out': _normal(ks[19], (N_ODD, C_HEADS * C_V, d), (C_HEADS * C_V) ** -0.5),
        'm_wq': _normal(ks[20], (DEPTH, d, d), d ** -0.5),
        'm_wk': _normal(ks[21], (DEPTH, d, d), d ** -0.5),
        'm_wv': _normal(ks[22], (DEPTH, d, d), d ** -0.5),
        'm_wo': _normal(ks[23], (DEPTH, d, d), d ** -0.5),
        'f_w1': _normal(ks[24], (DEPTH, d, D_FF), d ** -0.5),
        'f_w2': _normal(ks[25], (DEPTH, D_FF, d), D_FF ** -0.5),
    }


def reference(x, mem, positions, norm_mix_g, norm_mem_q_g, norm_mem_kv_g, norm_ffn_g,
              final_norm_g, ab_w_in, a_v_norm_g, a_w_s, a_b_s, b_conv_w, ab_w_out,
              c_w_in, c_q_norm_g, c_kv_norm_g, c_w_uq, c_w_ukv, c_w_out,
              m_wq, m_wk, m_wv, m_wo, f_w1, f_w2):
    for layer in range(DEPTH):
        xn = rmsnorm(x, norm_mix_g[layer])
        if layer % 2 == 0:
            e = layer // 2
            x = x + mixer_gmlp_conv(xn, ab_w_in[e], a_v_norm_g[e], a_w_s[e], a_b_s[e],
                                    b_conv_w[e], ab_w_out[e])
        else:
            o = layer // 2
            x = x + mixer_mla(xn, positions, c_w_in[o], c_q_norm_g[o], c_kv_norm_g[o],
                              c_w_uq[o], c_w_ukv[o], c_w_out[o])
        x = x + mem_cross_attention(rmsnorm(x, norm_mem_q_g[layer]),
                                    rmsnorm(mem, norm_mem_kv_g[layer]),
                                    m_wq[layer], m_wk[layer], m_wv[layer], m_wo[layer])
        x = x + squared_relu_mlp(rmsnorm(x, norm_ffn_g[layer]), f_w1[layer], f_w2[layer])
    return rmsnorm(x, final_norm_g)
```

```cpp
#include <hip/hip_runtime.h>
#include <cstdio>
#include <cstdint>
#include <cmath>

#ifndef PHM
#define PHM 0xFFFFF
#endif
#ifndef MK_PER_PHASE
#define MK_PER_PHASE 0
#endif

namespace pg8 {
#define PG8_LAS __attribute__((address_space(3)))
typedef unsigned short bf16_t;
typedef short bf16x8 __attribute__((ext_vector_type(8)));
typedef float f32x4 __attribute__((ext_vector_type(4)));
typedef unsigned u32x4 __attribute__((ext_vector_type(4)));
constexpr int BM = 256, BK = 64, HALF = 128, HTB = HALF * BK * 2, STAGE_BYTES = 8 * HTB, NXCD = 8, WGM = 8;

__host__ __device__ __forceinline__ int lds_byte(int r, int c) { const int st = (r >> 4) * 2 + (c >> 5), rr = r & 15, cc = c & 31, ob = rr * 64 + cc * 2; return st * 1024 + (ob ^ (((ob >> 9) & 1) << 5)); }
__host__ __device__ __forceinline__ void stage_rc(int b, int& R, int& C) { const int st = b / 1024, sb = b % 1024, swz = sb ^ (((sb >> 9) & 1) << 5); R = (st >> 1) * 16 + swz / 64; C = (st & 1) * 32 + (swz % 64) / 2; }
__host__ __device__ __forceinline__ int perm32(int rho) { const int n = rho >> 4, i = rho & 15; return 8 * (i >> 2) + 4 * n + (i & 3); }

struct Unit { int pm, pn, z0, z1; };
struct Gemm { const bf16_t* A; const bf16_t* Bt; int lda, ldb, K, nM, nN, nZ0, nZ1; long aZ0, aZ1, bZ0, bZ1; };

struct Order {
    int nN, nwg, G, c, lgM, lgZ0, mN;
    __device__ __forceinline__ void init(const Gemm& g, int G_, int c_) { nN = g.nN; nwg = g.nM * g.nZ0 * g.nZ1 * g.nN; G = G_; c = c_;
        lgM = 31 - __builtin_clz(g.nM); lgZ0 = 31 - __builtin_clz(g.nZ0); mN = ((1 << 20) + g.nN - 1) / g.nN; }
    __device__ __forceinline__ bool next(int i, Unit& u) const {
        const int L = i * G + c; if (L >= nwg) return false;
        const int wgid = (L & 7) * (nwg >> 3) + (L >> 3);
        const int w8 = wgid >> 3, gid = (int)(((unsigned)w8 * (unsigned)mN) >> 20);
        const int gm = gid * 8 + (wgid & 7); u.pn = w8 - gid * nN;
        u.pm = gm & ((1 << lgM) - 1); const int z = gm >> lgM; u.z0 = z & ((1 << lgZ0) - 1); u.z1 = z >> lgZ0; return true;
    }
};

__device__ __forceinline__ unsigned cvt_pk_bf16(float lo, float hi) { unsigned r; asm volatile("v_cvt_pk_bf16_f32 %0, %1, %2" : "=v"(r) : "v"(lo), "v"(hi)); return r; }

enum { EP_BF16 = 0, EP_RELU2 = 1, EP_RESID = 2, EP_F32S = 3 };
template <int MODE> struct Epi {
    static constexpr bool PERM = (MODE == EP_BF16 || MODE == EP_RELU2);
    void* out; const float* src; int ldc, rM, rZ0, rZ1, cZ0, cZ1; float scale;
    __device__ __forceinline__ void operator()(const f32x4 (&acc)[2][2][4][2], const Unit& u, int wr, int wc, int fr, int fq) const {
        const int row0 = u.pm * rM + u.z0 * rZ0 + u.z1 * rZ1 + wr * 64 + fr;
        const int colb = u.pn * BM + u.z0 * cZ0 + u.z1 * cZ1 + wc * 32;
        if constexpr (PERM) {
            bf16_t* O = (bf16_t*)out; const int col0 = colb + 8 * fq;
#pragma unroll
            for (int ai = 0; ai < 2; ++ai)
#pragma unroll
                for (int m = 0; m < 4; ++m) { bf16_t* rowp = O + (size_t)(row0 + ai * HALF + m * 16) * ldc + col0;
#pragma unroll
                    for (int bj = 0; bj < 2; ++bj) { f32x4 v0 = acc[ai][bj][m][0], v1 = acc[ai][bj][m][1];
                        if constexpr (MODE == EP_RELU2) {
#pragma unroll
                            for (int j = 0; j < 4; ++j) { const float a = fmaxf(v0[j], 0.f), b = fmaxf(v1[j], 0.f); v0[j] = a * a; v1[j] = b * b; } }
                        u32x4 w; w.x = cvt_pk_bf16(v0[0], v0[1]); w.y = cvt_pk_bf16(v0[2], v0[3]); w.z = cvt_pk_bf16(v1[0], v1[1]); w.w = cvt_pk_bf16(v1[2], v1[3]);
                        *(u32x4*)(rowp + bj * HALF) = w; } }
        } else {
            float* C = (float*)out; const int col0 = colb + 4 * fq;
#pragma unroll
            for (int ai = 0; ai < 2; ++ai)
#pragma unroll
                for (int m = 0; m < 4; ++m) { const size_t off = (size_t)(row0 + ai * HALF + m * 16) * ldc + col0;
#pragma unroll
                    for (int bj = 0; bj < 2; ++bj)
#pragma unroll
                        for (int n = 0; n < 2; ++n) {
                            if constexpr (MODE == EP_RESID) { const f32x4 bs = *(const f32x4*)(src + off + bj * HALF + n * 16); *(f32x4*)(C + off + bj * HALF + n * 16) = bs + acc[ai][bj][m][n]; }
                            else { *(f32x4*)(C + off + bj * HALF + n * 16) = acc[ai][bj][m][n] * scale; } }
                    if constexpr (MODE == EP_RESID) asm volatile("" ::: "memory"); }
        }
    }
};

template <class EpiT, bool ALIGN_EPI>
__device__ __forceinline__ void gemm_phase(PG8_LAS unsigned char* lds, const Gemm g, const Order& S, const EpiT& E) {
    int tid = threadIdx.x; asm volatile("" : "+v"(tid));
    const int wid = __builtin_amdgcn_readfirstlane(tid >> 6), lane = tid & 63, wr = wid >> 2, wc = wid & 3, fr = lane & 15, fq = lane >> 4;
    const int K = g.K, nt = K / BK;
    unsigned voffA[2], voffB[2];
#pragma unroll
    for (int i = 0; i < 2; ++i) { int R, C; stage_rc(tid * 16 + i * 8192, R, C); const int Rb = EpiT::PERM ? ((R & ~31) + perm32(R & 31)) : R;
        voffA[i] = (unsigned)(R * g.lda + C) * 2u; voffB[i] = (unsigned)(Rb * g.ldb + C) * 2u; }
    const size_t kstep = (size_t)(BK * 2);
    const size_t hstepA = (size_t)HALF * g.lda * 2, hstepB = (size_t)HALF * g.ldb * 2;
    const unsigned ldsw = (unsigned)wid * 1024u;
    const int aoff = lds_byte(wr * 64 + fr, fq * 8), boff = lds_byte(wc * 32 + fr, fq * 8);
#define PG8_SA(b, h) (((b) * 2 + (h)) * HTB)
#define PG8_SB(b, h) ((4 + (b) * 2 + (h)) * HTB)
#define PG8_STAGE(bufoff, gbase, voff) do { _Pragma("unroll") for (int _i = 0; _i < 2; ++_i) \
        __builtin_amdgcn_global_load_lds((const unsigned*)((const char*)(gbase) + (voff)[_i]), (PG8_LAS unsigned*)(lds + (bufoff) + ldsw + _i * 8192), 16, 0, 0); } while (0)
#define PG8_LDA(dst, b, h) do { _Pragma("unroll") for (int m = 0; m < 4; ++m) _Pragma("unroll") for (int k = 0; k < 2; ++k) dst[m][k] = *(const PG8_LAS bf16x8*)(lds + PG8_SA(b, h) + aoff + m * 2048 + k * 1024); } while (0)
#define PG8_LDB(dst, b, h) do { _Pragma("unroll") for (int n = 0; n < 2; ++n) _Pragma("unroll") for (int k = 0; k < 2; ++k) dst[n][k] = *(const PG8_LAS bf16x8*)(lds + PG8_SB(b, h) + boff + n * 2048 + k * 1024); } while (0)
#define PG8_MMA(ai, bj, At, Bt) do { __builtin_amdgcn_s_setprio(1); _Pragma("unroll") for (int m = 0; m < 4; ++m) _Pragma("unroll") for (int n = 0; n < 2; ++n) _Pragma("unroll") for (int k = 0; k < 2; ++k) \
        acc[ai][bj][m][n] = __builtin_amdgcn_mfma_f32_16x16x32_bf16(Bt[n][k], At[m][k], acc[ai][bj][m][n], 0, 0, 0); __builtin_amdgcn_s_setprio(0); } while (0)
#define PG8_WAIT_V(n) asm volatile("s_waitcnt vmcnt(" #n ")" ::: "memory")
#define PG8_WAIT_L(n) asm volatile("s_waitcnt lgkmcnt(" #n ")" ::: "memory")
#define PG8_BAR __builtin_amdgcn_s_barrier()
#define PG8_SCHED __builtin_amdgcn_sched_barrier(0)
#define PG8_TILEA(u) ((const char*)(g.A + (u).z0 * g.aZ0 + (u).z1 * g.aZ1 + (long)(u).pm * BM * g.lda))
#define PG8_TILEB(u) ((const char*)(g.Bt + (u).z0 * g.bZ0 + (u).z1 * g.bZ1 + (long)(u).pn * BM * g.ldb))
    Unit cur, nxt; int ui = 0;
    if (!S.next(0, cur)) return;
    f32x4 acc[2][2][4][2];
#pragma unroll
    for (int a = 0; a < 2; ++a)
#pragma unroll
        for (int b = 0; b < 2; ++b)
#pragma unroll
            for (int m = 0; m < 4; ++m)
#pragma unroll
                for (int n = 0; n < 2; ++n) acc[a][b][m][n] = (f32x4){0.f, 0.f, 0.f, 0.f};
    bf16x8 At[4][2], B0[2][2], B1[2][2];
    const char* cA = PG8_TILEA(cur); const char* cB = PG8_TILEB(cur);
    PG8_STAGE(PG8_SB(0, 0), cB, voffB); PG8_STAGE(PG8_SB(0, 1), cB + hstepB, voffB); PG8_STAGE(PG8_SA(0, 0), cA, voffA); PG8_STAGE(PG8_SA(0, 1), cA + hstepA, voffA);
    if (wr == 1) PG8_BAR;
    PG8_WAIT_V(2); PG8_BAR;
    PG8_STAGE(PG8_SB(1, 0), cB + kstep, voffB); PG8_STAGE(PG8_SA(1, 0), cA + kstep, voffA); PG8_STAGE(PG8_SB(1, 1), cB + hstepB + kstep, voffB);
    PG8_WAIT_V(6); PG8_BAR;
    for (;;) {
        const bool has_next = S.next(ui + 1, nxt);
        const char* nA = has_next ? PG8_TILEA(nxt) : cA; const char* nB = has_next ? PG8_TILEB(nxt) : cB;
        for (int t = 0; t < nt; t += 2) {
            const bool last = (t == nt - 2);
            const char* a1 = cA + (size_t)(t + 1) * kstep;
            const char* a2 = last ? nA : cA + (size_t)(t + 2) * kstep; const char* b2 = last ? nB : cB + (size_t)(t + 2) * kstep;
            const char* a3 = a2 + kstep; const char* b3 = b2 + kstep;
            PG8_LDB(B0, 0, 0); PG8_LDB(B1, 0, 1); PG8_SCHED; PG8_LDA(At, 0, 0); PG8_STAGE(PG8_SA(1, 1), a1 + hstepA, voffA);
            PG8_WAIT_V(8); PG8_WAIT_L(0); PG8_BAR; PG8_MMA(0, 0, At, B0); PG8_MMA(0, 1, At, B1); PG8_BAR; PG8_SCHED;
            PG8_LDA(At, 0, 1); PG8_STAGE(PG8_SB(0, 0), b2, voffB); PG8_STAGE(PG8_SB(0, 1), b2 + hstepB, voffB); PG8_STAGE(PG8_SA(0, 0), a2, voffA);
            PG8_WAIT_V(8); PG8_WAIT_L(0); PG8_BAR; PG8_MMA(1, 0, At, B0); PG8_MMA(1, 1, At, B1); PG8_BAR; PG8_SCHED;
            PG8_LDB(B0, 1, 0); PG8_LDB(B1, 1, 1); PG8_SCHED; PG8_LDA(At, 1, 0); PG8_STAGE(PG8_SA(0, 1), a2 + hstepA, voffA);
            PG8_WAIT_V(8); PG8_WAIT_L(0); PG8_BAR; PG8_MMA(0, 0, At, B0); PG8_MMA(0, 1, At, B1); PG8_BAR; PG8_SCHED;
            PG8_LDA(At, 1, 1); PG8_STAGE(PG8_SB(1, 0), b3, voffB); PG8_STAGE(PG8_SB(1, 1), b3 + hstepB, voffB); PG8_STAGE(PG8_SA(1, 0), a3, voffA);
            PG8_WAIT_V(8); PG8_WAIT_L(0); PG8_BAR; PG8_MMA(1, 0, At, B0); PG8_MMA(1, 1, At, B1); PG8_BAR; PG8_SCHED;
        }
        if constexpr (ALIGN_EPI) { if (wr == 0) PG8_BAR; }
        E(acc, cur, wr, wc, fr, fq);
        if (!has_next) break;
#pragma unroll
        for (int a = 0; a < 2; ++a)
#pragma unroll
            for (int b = 0; b < 2; ++b)
#pragma unroll
                for (int m = 0; m < 4; ++m)
#pragma unroll
                    for (int n = 0; n < 2; ++n) acc[a][b][m][n] = (f32x4){0.f, 0.f, 0.f, 0.f};
        cur = nxt; cA = nA; cB = nB; ++ui;
        if constexpr (ALIGN_EPI) { if (wr == 1) PG8_BAR; }
    }
    PG8_WAIT_V(0);
    if constexpr (!ALIGN_EPI) { if (wr == 0) PG8_BAR; }
    PG8_BAR;
#undef PG8_SA
#undef PG8_SB
#undef PG8_STAGE
#undef PG8_LDA
#undef PG8_LDB
#undef PG8_MMA
#undef PG8_WAIT_V
#undef PG8_WAIT_L
#undef PG8_BAR
#undef PG8_SCHED
#undef PG8_TILEA
#undef PG8_TILEB
}
}

constexpr int NWAVES = 8;
constexpr int BATCH = 16, SEQ = 2048, D = 2048, M = BATCH * SEQ, NMEM = 256, MMEM = BATCH * NMEM, DEPTH = 4;
constexpr int AB_IN = 5120, C_IN = 832, C_INP = 1024, DFF = 8192;
constexpr float RMS_EPS = 1e-6f;

constexpr size_t MiB = 1u << 20;
constexpr size_t WS_CTL = 0, CTL_ZERO_BYTES = 1 * MiB;
constexpr size_t WS_ROPE = 8 * MiB;
constexpr size_t WS_W = 16 * MiB;
constexpr size_t W_MIXA = 0, W_UQ = 4 * MiB, W_UK = 8 * MiB, W_UV = 9 * MiB, W_MIXB = 20 * MiB, W_WQ = 28 * MiB, W_WKV = 36 * MiB, W_WO = 52 * MiB, W_W1 = 60 * MiB, W_W2 = 92 * MiB;
constexpr size_t WS_XN = 144 * MiB;
constexpr size_t WS_BIG = 272 * MiB;
constexpr size_t B_Q = 0, B_KN = 192 * MiB, B_VT = 320 * MiB, B_CQN = 448 * MiB, B_CKVN = 480 * MiB, B_KR = 496 * MiB;
constexpr size_t B_S = 0, B_P = 128 * MiB;
constexpr size_t WS_WQKT = 784 * MiB, WS_VWOT = 848 * MiB, WS_KVM = 912 * MiB, WS_MEMN = 944 * MiB, WS_WSM = 960 * MiB, WS_END = 961 * MiB;
constexpr int CW_TMO = 0, CW_BAR = 4096;

constexpr int RING_OFF = 0, RING_BYTES = 131072;
constexpr int LDSCTL_OFF = RING_BYTES, MISC_OFF = LDSCTL_OFF + 320;
constexpr int LDS_BYTES = 147456;
constexpr int PTAB_OFF = LDSCTL_OFF + 512;
constexpr int INVF_OFF = LDSCTL_OFF + 1024;

#define LAS __attribute__((address_space(3)))
typedef unsigned short bf16;
typedef unsigned v4u __attribute__((ext_vector_type(4)));
typedef unsigned v2u __attribute__((ext_vector_type(2)));
typedef float f32x4 __attribute__((ext_vector_type(4)));
typedef short bf16x8 __attribute__((ext_vector_type(8)));
typedef short s16x4 __attribute__((ext_vector_type(4)));
#define LDS_WAIT() asm volatile("s_waitcnt lgkmcnt(0)" ::: "memory")

__device__ __forceinline__ float bf2f(unsigned short b) { return __uint_as_float(((unsigned)b) << 16); }
__device__ __forceinline__ float bflo(unsigned w) { return __uint_as_float(w << 16); }
__device__ __forceinline__ float bfhi(unsigned w) { return __uint_as_float(w & 0xffff0000u); }
__device__ __forceinline__ unsigned pk2(float lo, float hi) { return pg8::cvt_pk_bf16(lo, hi); }
__device__ __forceinline__ float gelu_tanh(float x) {
    const float y = 0.7978845608028654f * (x + 0.044715f * x * x * x);
    return x / (1.0f + __expf(-2.0f * y));
}

#define XB_TMO      128
#define XB_XCNT(j)  (256  + 64 * (j))
#define XB_XSUB(j)  (1280 + 64 * (j))
#define XB_XGEN(j)  (2304 + 64 * (j))
#define XB_TOP      3328
#define XB_TOPGEN   3392
#define XCD_BAR_WORDS 3456
#define XB_SPIN_CAP (1u << 18)
__device__ __forceinline__ unsigned xb_ld(unsigned* p)              { return __hip_atomic_load(p, __ATOMIC_RELAXED, __HIP_MEMORY_SCOPE_AGENT); }
__device__ __forceinline__ unsigned xb_add(unsigned* p, unsigned v) { return __hip_atomic_fetch_add(p, v, __ATOMIC_RELAXED, __HIP_MEMORY_SCOPE_AGENT); }
__device__ __forceinline__ unsigned xb_xcc_id() { return (unsigned)__builtin_amdgcn_s_getreg((3 << 11) | 20) & 0xFu; }
#define XB_SPIN(cond, bar) do { unsigned _sp = 0; while (cond) { __builtin_amdgcn_s_sleep(1); \
    if ((++_sp & 255u) == 0u) { if (xb_ld(&(bar)[XB_TMO])) break; if (_sp > XB_SPIN_CAP) { atomicAdd(&(bar)[XB_TMO], 1u); break; } } } } while (0)
struct XcdBarrier { unsigned* bar; unsigned x; volatile LAS unsigned* st; };
__device__ __forceinline__ XcdBarrier xcd_barrier_post(unsigned* bar, volatile LAS unsigned* st) {
    XcdBarrier b; b.bar = bar; b.x = xb_xcc_id(); b.st = st;
    if (threadIdx.x == 0) (void)xb_add(&bar[XB_XCNT(b.x)], 1u);
    return b;
}
__device__ __forceinline__ void xcd_barrier_complete(unsigned* bar, unsigned x, unsigned& nloc, unsigned& nx) {
    const unsigned G = gridDim.x * gridDim.y * gridDim.z;
    unsigned sum, cnt, mine, sp = 0u;
    for (;;) {
        sum = 0u; cnt = 0u; mine = 0u;
#pragma unroll
        for (unsigned j = 0; j < 16; ++j) { const unsigned c = xb_ld(&bar[XB_XCNT(j)]); sum += c; cnt += (c > 0u) ? 1u : 0u; mine = (j == x) ? c : mine; }
        if (sum == G) break;
        __builtin_amdgcn_s_sleep(1);
        if ((++sp & 255u) == 0u) { if (xb_ld(&bar[XB_TMO])) break; if (sp > XB_SPIN_CAP) { atomicAdd(&bar[XB_TMO], 1u); break; } }
    }
    nloc = mine > 0u ? mine : 1u; nx = cnt > 0u ? cnt : 1u;
}
__device__ __forceinline__ void xcd_barrier(const XcdBarrier& b) {
    asm volatile("s_waitcnt vmcnt(0)" ::: "memory");
    __syncthreads();
    if (threadIdx.x == 0) {
        unsigned* bar = b.bar;
        __builtin_amdgcn_s_waitcnt(0);
        unsigned nloc = b.st[0], nx = b.st[1];
        if (nloc == 0u) { xcd_barrier_complete(bar, b.x, nloc, nx); b.st[0] = nloc; b.st[1] = nx; }
        const unsigned old = xb_add(&bar[XB_XSUB(b.x)], 1u);
        const unsigned gen = old / nloc;
        if (old + 1u == (gen + 1u) * nloc) {
            __builtin_amdgcn_fence(__ATOMIC_RELEASE, "agent");
            asm volatile("s_waitcnt vmcnt(0)" ::: "memory");
            const unsigned og = xb_add(&bar[XB_TOP], 1u);
            const unsigned tg = og / nx;
            if (og + 1u == (tg + 1u) * nx) xb_add(&bar[XB_TOPGEN], 1u);
            else XB_SPIN(xb_ld(&bar[XB_TOPGEN]) == tg, bar);
            __builtin_amdgcn_fence(__ATOMIC_ACQUIRE, "agent");
            xb_add(&bar[XB_XGEN(b.x)], 1u);
            asm volatile("s_waitcnt vmcnt(0)" ::: "memory");
        } else {
            XB_SPIN(xb_ld(&bar[XB_XGEN(b.x)]) == gen, bar);
            __builtin_amdgcn_fence(__ATOMIC_ACQUIRE, "agent");
            asm volatile("s_waitcnt vmcnt(0)" ::: "memory");
        }
    }
    __syncthreads();
}

__device__ __forceinline__ float wave_sum(float v) {
#pragma unroll
    for (int o = 1; o < 64; o <<= 1) v += __shfl_xor(v, o);
    return v;
}
__device__ __forceinline__ float wave_max(float v) {
#pragma unroll
    for (int o = 1; o < 64; o <<= 1) v = fmaxf(v, __shfl_xor(v, o));
    return v;
}

__device__ __forceinline__ unsigned char* ldptr(LAS unsigned char* lds, int k) {
    const volatile LAS unsigned* p = (const volatile LAS unsigned*)(lds + PTAB_OFF) + 2 * k;
    const unsigned lo = __builtin_amdgcn_readfirstlane(p[0]), hi = __builtin_amdgcn_readfirstlane(p[1]);
    return (unsigned char*)(__attribute__((address_space(1))) unsigned char*)(((unsigned long long)hi << 32) | (unsigned long long)lo);
}
template <int MODE>
__device__ __forceinline__ void transpose_item(const float* W, int K, int N, bf16* WT, bf16* WT2, int row_off, LAS float* scr, int item, int lane) {
    const int nblk = N / 32, kb = item / nblk, nb = item % nblk, k0 = 64 * kb, n0 = 32 * nb;
#pragma unroll 8
    for (int i = 0; i < 32; ++i) { const int kk = 2 * i + (lane >> 5); scr[kk * 33 + (lane & 31)] = W[(size_t)(k0 + kk) * N + n0 + (lane & 31)]; }
    LDS_WAIT(); asm volatile("" ::: "memory");
    bf16* dst = WT; int r0 = row_off + n0;
    if (MODE == 1) { const int h = n0 >> 8, w = n0 & 255; if (w < 128) { dst = WT; r0 = h * 128 + w; } else { dst = WT2; r0 = h * 128 + w - 128; } }
    const int c = lane & 7;
#pragma unroll
    for (int j = 0; j < 4; ++j) { const int n = (lane >> 3) + 8 * j; const LAS float* s = scr + (8 * c) * 33 + n;
        v4u o; o.x = pk2(s[0 * 33], s[1 * 33]); o.y = pk2(s[2 * 33], s[3 * 33]); o.z = pk2(s[4 * 33], s[5 * 33]); o.w = pk2(s[6 * 33], s[7 * 33]);
        *(v4u*)(dst + (size_t)(r0 + n) * K + k0 + 8 * c) = o; }
    LDS_WAIT(); asm volatile("" ::: "memory");
}

__device__ __forceinline__ void norm_rows_bf16(const float* X, const float* gain, bf16* out, int nrows, int gw, int NGW, int lane) {
    for (int m = gw; m < nrows; m += NGW) {
        const f32x4* xr = (const f32x4*)(X + (size_t)m * D) + lane;
        f32x4 v[8]; float s = 0.f;
#pragma unroll
        for (int j = 0; j < 8; ++j) { v[j] = xr[64 * j]; s += (v[j].x * v[j].x + v[j].y * v[j].y) + (v[j].z * v[j].z + v[j].w * v[j].w); }
        const float r = 1.0f / sqrtf(wave_sum(s) * (1.0f / D) + RMS_EPS);
        v2u* o8 = (v2u*)(out + (size_t)m * D) + lane;
#pragma unroll
        for (int j = 0; j < 8; ++j) { const f32x4 gv = ((const f32x4*)gain)[lane + 64 * j]; v2u w; w.x = pk2(v[j].x * r * gv.x, v[j].y * r * gv.y); w.y = pk2(v[j].z * r * gv.z, v[j].w * r * gv.w); o8[64 * j] = w; }
    }
}

namespace att {
constexpr int KT_BYTES = 64 * 384, VROW = 144, VT_BYTES = 128 * VROW, BUF = KT_BYTES + VT_BYTES;
struct T { const bf16* Q; const bf16* KN; const bf16* KR; const bf16* VT; bf16* O; const float* rope; };
constexpr float QK_SCALE = 0.07216878364870322f;
constexpr float C2 = QK_SCALE * 1.4426950408889634f;

__device__ __forceinline__ void unit(LAS unsigned char* lds, const T& t, int b, int h, int u, int tid, int wave, int lane) {
    const int r = lane & 15, g = lane >> 4;
    const int q0 = 256 * u + 32 * wave, cq = q0 >> 6, ntiles = 4 * u + 4;
    const size_t rowb = (size_t)b * SEQ;
    bf16x8 qf[2][6];
#pragma unroll
    for (int qs = 0; qs < 2; ++qs) {
        const bf16* qp = t.Q + (rowb + q0 + 16 * qs + r) * 3072 + h * 192 + 8 * g;
#pragma unroll
        for (int s = 0; s < 6; ++s) qf[qs][s] = *(const bf16x8*)(qp + 32 * s);
        const float* rp = t.rope + (rowb + q0 + 16 * qs + r) * 64 + 8 * g;
        const f32x4 c0 = *(const f32x4*)rp, c1 = *(const f32x4*)(rp + 4), s0 = *(const f32x4*)(rp + 32), s1 = *(const f32x4*)(rp + 36);
        const float cs[8] = {c0.x, c0.y, c0.z, c0.w, c1.x, c1.y, c1.z, c1.w}, sn[8] = {s0.x, s0.y, s0.z, s0.w, s1.x, s1.y, s1.z, s1.w};
        bf16x8 x1 = qf[qs][4], x2 = qf[qs][5]; float o1[8], o2[8];
#pragma unroll
        for (int e = 0; e < 8; ++e) { const float a = bf2f((unsigned short)x1[e]), bb = bf2f((unsigned short)x2[e]); o1[e] = a * cs[e] - bb * sn[e]; o2[e] = bb * cs[e] + a * sn[e]; }
        v4u w1, w2; w1.x = pk2(o1[0], o1[1]); w1.y = pk2(o1[2], o1[3]); w1.z = pk2(o1[4], o1[5]); w1.w = pk2(o1[6], o1[7]);
        w2.x = pk2(o2[0], o2[1]); w2.y = pk2(o2[2], o2[3]); w2.z = pk2(o2[4], o2[5]); w2.w = pk2(o2[6], o2[7]);
        qf[qs][4] = __builtin_bit_cast(bf16x8, w1); qf[qs][5] = __builtin_bit_cast(bf16x8, w2);
    }
    v4u kreg[3], vreg[2];
#define ATT_LOAD(jt) do { int t2 = tid; asm volatile("" : "+v"(t2)); \
        _Pragma("unroll") for (int i = 0; i < 3; ++i) { const int ch = t2 + 512 * i, key = ch / 24, c16 = ch % 24; const size_t krow = rowb + (size_t)(jt) * 64 + key; \
            const bf16* sp = (c16 < 16) ? t.KN + krow * 2048 + h * 128 + c16 * 8 : t.KR + krow * 64 + (c16 - 16) * 8; kreg[i] = *(const v4u*)sp; } \
        _Pragma("unroll") for (int i = 0; i < 2; ++i) { const int ch = t2 + 512 * i, dv = ch >> 3, c16 = ch & 7; \
            vreg[i] = *(const v4u*)(t.VT + ((size_t)b * 2048 + h * 128 + dv) * 2048 + (jt) * 64 + c16 * 8); } } while (0)
#define ATT_STORE(bo) do { int t2 = tid; asm volatile("" : "+v"(t2)); \
        _Pragma("unroll") for (int i = 0; i < 3; ++i) { const int ch = t2 + 512 * i, key = ch / 24, c16 = ch % 24; *(LAS v4u*)(lds + (bo) + key * 384 + ((c16 ^ (key & 7)) << 4)) = kreg[i]; } \
        _Pragma("unroll") for (int i = 0; i < 2; ++i) { const int ch = t2 + 512 * i, dv = ch >> 3, c16 = ch & 7; *(LAS v4u*)(lds + (bo) + KT_BYTES + dv * VROW + c16 * 16) = vreg[i]; } } while (0)
    float mrow[2] = {-1e30f, -1e30f}, lsum[2] = {0.f, 0.f};
    f32x4 oacc[8][2];
#pragma unroll
    for (int tt = 0; tt < 8; ++tt) { oacc[tt][0] = (f32x4){0.f, 0.f, 0.f, 0.f}; oacc[tt][1] = (f32x4){0.f, 0.f, 0.f, 0.f}; }
    const int offE = (g ^ (r & 7)) << 4, offO = offE ^ 64;
    const int kbase = r * 384, vbase = KT_BYTES + r * VROW + 8 * g;

    ATT_LOAD(0); ATT_STORE(0);
    __syncthreads();
    for (int jt = 0; jt < ntiles; ++jt) {
        const int bo = (jt & 1) * BUF, bn = ((jt + 1) & 1) * BUF;
        const bool more = (jt + 1 < ntiles);
        if (more) ATT_LOAD(jt + 1);
        if (jt <= cq) {
            f32x4 sc[4][2];
#pragma unroll
            for (int kt = 0; kt < 4; ++kt) { sc[kt][0] = (f32x4){0.f, 0.f, 0.f, 0.f}; sc[kt][1] = (f32x4){0.f, 0.f, 0.f, 0.f}; }
#pragma unroll
            for (int kt = 0; kt < 4; ++kt)
#pragma unroll
                for (int s = 0; s < 6; ++s) {
                    const bf16x8 kf = *(const LAS bf16x8*)(lds + bo + kbase + kt * (16 * 384) + (s >> 1) * 128 + ((s & 1) ? offO : offE));
                    sc[kt][0] = __builtin_amdgcn_mfma_f32_16x16x32_bf16(kf, qf[0][s], sc[kt][0], 0, 0, 0);
                    sc[kt][1] = __builtin_amdgcn_mfma_f32_16x16x32_bf16(kf, qf[1][s], sc[kt][1], 0, 0, 0);
                }
            bf16x8 pf[2][2];
#pragma unroll
            for (int qs = 0; qs < 2; ++qs) {
                float mx = sc[0][qs][0];
#pragma unroll
                for (int kt = 0; kt < 4; ++kt)
#pragma unroll
                    for (int j = 0; j < 4; ++j) mx = fmaxf(mx, sc[kt][qs][j]);
                mx = fmaxf(mx, __shfl_xor(mx, 16)); mx = fmaxf(mx, __shfl_xor(mx, 32));
                const float mnew = fmaxf(mrow[qs], mx), alpha = __builtin_amdgcn_exp2f((mrow[qs] - mnew) * C2), mc = mnew * C2;
                mrow[qs] = mnew;
                float ps = 0.f; float p[4][4];
#pragma unroll
                for (int kt = 0; kt < 4; ++kt)
#pragma unroll
                    for (int j = 0; j < 4; ++j) { p[kt][j] = __builtin_amdgcn_exp2f(sc[kt][qs][j] * C2 - mc); ps += p[kt][j]; }
                lsum[qs] = lsum[qs] * alpha + ps;
#pragma unroll
                for (int s2 = 0; s2 < 2; ++s2) { v4u w; w.x = pk2(p[2 * s2][0], p[2 * s2][1]); w.y = pk2(p[2 * s2][2], p[2 * s2][3]); w.z = pk2(p[2 * s2 + 1][0], p[2 * s2 + 1][1]); w.w = pk2(p[2 * s2 + 1][2], p[2 * s2 + 1][3]);
                    pf[qs][s2] = __builtin_bit_cast(bf16x8, w); }
#pragma unroll
                for (int tt = 0; tt < 8; ++tt) oacc[tt][qs] = oacc[tt][qs] * alpha;
            }
#pragma unroll
            for (int tt = 0; tt < 8; ++tt)
#pragma unroll
                for (int s2 = 0; s2 < 2; ++s2) {
                    const v2u lo = *(const LAS v2u*)(lds + bo + vbase + tt * (16 * VROW) + s2 * 64);
                    const v2u hi = *(const LAS v2u*)(lds + bo + vbase + tt * (16 * VROW) + s2 * 64 + 32);
                    const v4u vv = {lo.x, lo.y, hi.x, hi.y}; const bf16x8 vf = __builtin_bit_cast(bf16x8, vv);
                    oacc[tt][0] = __builtin_amdgcn_mfma_f32_16x16x32_bf16(vf, pf[0][s2], oacc[tt][0], 0, 0, 0);
                    oacc[tt][1] = __builtin_amdgcn_mfma_f32_16x16x32_bf16(vf, pf[1][s2], oacc[tt][1], 0, 0, 0);
                }
        }
        if (more) ATT_STORE(bn);
        __syncthreads();
    }
#undef ATT_LOAD
#undef ATT_STORE
#pragma unroll
    for (int qs = 0; qs < 2; ++qs) {
        float l = lsum[qs]; l += __shfl_xor(l, 16); l += __shfl_xor(l, 32);
        const float inv = 1.0f / l;
        bf16* op = t.O + (rowb + q0 + 16 * qs + r) * 2048 + h * 128 + 4 * g;
#pragma unroll
        for (int tt = 0; tt < 8; ++tt) { const f32x4 o = oacc[tt][qs] * inv; v2u w; w.x = pk2(o.x, o.y); w.y = pk2(o.z, o.w); *(v2u*)(op + 16 * tt) = w; }
    }
}
}

struct Args {
    const float* in[26]; float* out; unsigned char* ws; int ph_lo, ph_hi; float inv_freq[32];
};
constexpr int PH_PER_LAYER = 16, PH_FINAL = DEPTH * PH_PER_LAYER, PH_TOTAL = PH_FINAL + 1;

__global__ void __launch_bounds__(NWAVES * 64, 2) trunk_fwd(Args args) {
    extern __shared__ __attribute__((aligned(16))) unsigned char lds_raw[];
    LAS unsigned char* lds = (LAS unsigned char*)lds_raw;
    volatile LAS unsigned* MISC = (volatile LAS unsigned*)(lds + MISC_OFF);
    const int wave = __builtin_amdgcn_readfirstlane((int)threadIdx.x >> 6);
    const int G = gridDim.x, cid = blockIdx.x;
    const int gw = cid * NWAVES + wave, NGW = G * NWAVES, GT = G * NWAVES * 64;
    for (int u = threadIdx.x; u < (LDS_BYTES - LDSCTL_OFF) / 4; u += NWAVES * 64) ((LAS unsigned*)(lds + LDSCTL_OFF))[u] = 0u;
    __syncthreads();
    if (threadIdx.x == 0) {
        LAS unsigned long long* pt = (LAS unsigned long long*)(lds + PTAB_OFF);
#pragma unroll
        for (int k = 0; k < 26; ++k) pt[k] = (unsigned long long)args.in[k];
        pt[26] = (unsigned long long)args.out; pt[27] = (unsigned long long)args.ws;
        LAS float* fv = (LAS float*)(lds + INVF_OFF);
#pragma unroll
        for (int k = 0; k < 32; ++k) fv[k] = args.inv_freq[k];
    }
    __syncthreads();
#if MK_PER_PHASE
#define GRID_BAR() do { } while (0)
#else
    (void)xcd_barrier_post((unsigned*)(args.ws + WS_CTL) + CW_BAR, MISC + 8);
#define GRID_BAR() do { XcdBarrier b_; b_.bar = (unsigned*)(ldptr(lds, 27) + WS_CTL) + CW_BAR; unsigned x_ = xb_xcc_id(); asm volatile("" : "+s"(x_)); b_.x = x_; b_.st = MISC + 8; xcd_barrier(b_); } while (0)
#endif
    const int lo = args.ph_lo, hi = args.ph_hi;
#define IN(k) (lo <= (k) && (k) < hi)
#define BOTH(k) (IN(k) && IN((k) + 1))
#define SEAM(k) do { if (BOTH(k)) GRID_BAR(); } while (0)
#define INP(k) ((const float*)ldptr(lds, (k)))
#define PHASE_IDS() int tid = threadIdx.x; asm volatile("" : "+v"(tid)); const int lane = tid & 63, gtid = cid * (NWAVES * 64) + tid; (void)lane; (void)gtid
#define PHASE_PTRS() PHASE_IDS(); unsigned char* ws = ldptr(lds, 27); float* X = (float*)ldptr(lds, 26); unsigned char* W = ws + WS_W; bf16* XN = (bf16*)(ws + WS_XN); unsigned char* BIG = ws + WS_BIG; (void)X; (void)W; (void)XN; (void)BIG

    for (int layer = 0; layer < DEPTH; ++layer) {
        const int pb = layer * PH_PER_LAYER;
        const bool odd = (layer & 1) != 0; const int eo = layer >> 1;

        if (((PHM >> 0) & 1) && IN(pb + 0)) {
            PHASE_PTRS();
            LAS float* scr = (LAS float*)(lds + RING_OFF + wave * 16384);
            bf16* W_mixa = (bf16*)(W + W_MIXA); bf16* W_mixb = (bf16*)(W + W_MIXB); bf16* W_wkv = (bf16*)(W + W_WKV);
            int it = gw;
#define TR_JOB(MODE, Wsrc, KK, NN, DST, DST2, ROWOFF) { const int n_items = ((KK) / 64) * ((NN) / 32); for (; it < n_items; it += NGW) transpose_item<MODE>((Wsrc), (KK), (NN), (DST), (DST2), (ROWOFF), scr, it, lane); it -= n_items; }
            if (!odd) {
                TR_JOB(0, INP(8) + (size_t)eo * D * AB_IN, D, AB_IN, W_mixa, W_mixa, 0);
                TR_JOB(0, INP(13) + (size_t)eo * D * D, D, D, W_mixb, W_mixb, 0);
            } else {
                TR_JOB(0, INP(14) + (size_t)eo * D * C_IN, D, C_IN, W_mixa, W_mixa, 0);
                TR_JOB(0, INP(17) + (size_t)eo * 512 * 3072, 512, 3072, (bf16*)(W + W_UQ), (bf16*)(W + W_UQ), 0);
                TR_JOB(1, INP(18) + (size_t)eo * 256 * 4096, 256, 4096, (bf16*)(W + W_UK), (bf16*)(W + W_UV), 0);
                TR_JOB(0, INP(19) + (size_t)eo * D * D, D, D, W_mixb, W_mixb, 0);
            }
            TR_JOB(0, INP(21) + (size_t)layer * D * D, D, D, W_wkv, W_wkv, 0);
            TR_JOB(0, INP(22) + (size_t)layer * D * D, D, D, W_wkv, W_wkv, D);
            TR_JOB(0, INP(23) + (size_t)layer * D * D, D, D, (bf16*)(W + W_WO), (bf16*)(W + W_WO), 0);
            TR_JOB(0, INP(24) + (size_t)layer * D * DFF, D, DFF, (bf16*)(W + W_W1), (bf16*)(W + W_W1), 0);
            TR_JOB(0, INP(25) + (size_t)layer * DFF * D, DFF, D, (bf16*)(W + W_W2), (bf16*)(W + W_W2), 0);
#undef TR_JOB
            {
                const float* wq = INP(20) + (size_t)layer * D * D; v4u* dst = (v4u*)(W + W_WQ);
                for (int i = gtid; i < D * D / 8; i += GT) { const f32x4 a = ((const f32x4*)wq)[2 * i], b = ((const f32x4*)wq)[2 * i + 1];
                    v4u o; o.x = pk2(a.x, a.y); o.y = pk2(a.z, a.w); o.z = pk2(b.x, b.y); o.w = pk2(b.z, b.w); dst[i] = o; }
            }
            if (!odd) {
                const float* wsp = INP(10) + (size_t)eo * 8 * 128 * 128; bf16* WSM = (bf16*)(ws + WS_WSM);
                for (int i = gtid; i < 8 * 128 * 128; i += GT) { const int ii = (i >> 7) & 127, jj = i & 127; const float v = ((jj >> 6) <= (ii >> 6)) ? wsp[i] : 0.f; WSM[i] = (bf16)(pk2(v, 0.f) & 0xffffu); }
            }
            if (layer == 0) {
                const int* positions = (const int*)INP(2); float* ROPE = (float*)(ws + WS_ROPE); const LAS float* fv = (const LAS float*)(lds + INVF_OFF);
                for (int i = gtid; i < M * 32; i += GT) { const int row = i >> 5, fi = i & 31;
                    const float ang = (float)positions[row] * fv[fi];
                    const double rev = (double)ang * 0.15915494309189535; const float fr = (float)(rev - floor(rev));
                    ROPE[(size_t)row * 64 + fi] = __builtin_amdgcn_cosf(fr); ROPE[(size_t)row * 64 + 32 + fi] = __builtin_amdgcn_sinf(fr); }
            }
            norm_rows_bf16(INP(1), INP(5) + (size_t)layer * D, (bf16*)(ws + WS_MEMN), MMEM, gw, NGW, lane);
            norm_rows_bf16((layer == 0) ? INP(0) : (const float*)X, INP(3) + (size_t)layer * D, XN, M, gw, NGW, lane);
            __syncthreads();
        }
        SEAM(pb + 0);

        if (((PHM >> 1) & 1) && IN(pb + 1)) {
            {
                PHASE_PTRS();
                pg8::Gemm g{XN, (const bf16*)(W + W_MIXA), D, D, D, M / 256, odd ? C_INP / 256 : AB_IN / 256, 1, 1, 0, 0, 0, 0};
                pg8::Order S; S.init(g, G, cid);
                pg8::Epi<pg8::EP_BF16> E{(void*)BIG, nullptr, odd ? C_INP : AB_IN, 256, 0, 0, 0, 0, 1.f};
                pg8::gemm_phase<pg8::Epi<pg8::EP_BF16>, true>(lds + RING_OFF, g, S, E);
            }
            {
                PHASE_PTRS();
                pg8::Gemm g{(const bf16*)(ws + WS_MEMN), (const bf16*)(W + W_WKV), D, D, D, MMEM / 256, 2 * D / 256, 1, 1, 0, 0, 0, 0};
                pg8::Order S; S.init(g, G, cid);
                pg8::Epi<pg8::EP_BF16> E{(void*)(ws + WS_KVM), nullptr, 2 * D, 256, 0, 0, 0, 0, 1.f};
                pg8::gemm_phase<pg8::Epi<pg8::EP_BF16>, true>(lds + RING_OFF, g, S, E);
            }
        }
        SEAM(pb + 1);

        if (((PHM >> 2) & 1) && IN(pb + 2)) {
            if (!odd) {
                PHASE_PTRS();
                const bf16* Z = (const bf16*)BIG; const bf16* WSM = (const bf16*)(ws + WS_WSM);
                const float* vng = INP(9) + (size_t)eo * 1024; const float* bsp = INP(11) + (size_t)eo * 1024; const float* cw = INP(12) + (size_t)eo * 3 * 1024;
                for (int uidx = cid; uidx < 2048; uidx += G) {
                    const int nb = uidx >> 3, gq = uidx & 7; const size_t row0 = (size_t)nb * 128;
                    {
                        const int j = tid >> 2, qd = tid & 3;
                        const v4u* vp = (const v4u*)(Z + (row0 + j) * AB_IN + 1024 + gq * 128 + qd * 32);
                        float vals[32]; float ss = 0.f;
#pragma unroll
                        for (int k4 = 0; k4 < 4; ++k4) { const v4u w = vp[k4]; const unsigned ww[4] = {w.x, w.y, w.z, w.w};
#pragma unroll
                            for (int e = 0; e < 4; ++e) { const float a = gelu_tanh(bflo(ww[e])), b = gelu_tanh(bfhi(ww[e])); vals[k4 * 8 + 2 * e] = a; vals[k4 * 8 + 2 * e + 1] = b; ss += a * a + b * b; } }
                        ss += __shfl_xor(ss, 1); ss += __shfl_xor(ss, 2);
                        const float rinv = 1.0f / sqrtf(ss * (1.0f / 128.0f) + RMS_EPS);
                        const float* gp = vng + gq * 128 + qd * 32;
                        LAS bf16* vt = (LAS bf16*)(lds + RING_OFF);
#pragma unroll
                        for (int k = 0; k < 32; ++k) vt[(qd * 32 + k) * 136 + j] = (bf16)(pk2(vals[k] * rinv * gp[k], 0.f) & 0xffffu);
                    }
                    __syncthreads();
                    {
                        const int r = lane & 15, g4 = lane >> 4; const int irow = 16 * wave + r;
                        bf16x8 wf[4];
#pragma unroll
                        for (int s = 0; s < 4; ++s) wf[s] = *(const bf16x8*)(WSM + ((size_t)(gq * 128 + irow) * 128 + 32 * s + 8 * g4));
                        const float bs = bsp[gq * 128 + irow];
                        const bf16* up = Z + (row0 + irow) * AB_IN + gq * 128 + 4 * g4;
                        bf16* yp = XN + (row0 + irow) * D + gq * 128 + 4 * g4;
#pragma unroll
                        for (int t = 0; t < 8; ++t) {
                            f32x4 acc = (f32x4){0.f, 0.f, 0.f, 0.f};
#pragma unroll
                            for (int s = 0; s < 4; ++s) { const bf16x8 vf = *(const LAS bf16x8*)(lds + RING_OFF + (16 * t + r) * 272 + (32 * s + 8 * g4) * 2);
                                acc = __builtin_amdgcn_mfma_f32_16x16x32_bf16(vf, wf[s], acc, 0, 0, 0); }
                            const v2u uw = *(const v2u*)(up + 16 * t);
                            const float u0 = gelu_tanh(bflo(uw.x)), u1 = gelu_tanh(bfhi(uw.x)), u2 = gelu_tanh(bflo(uw.y)), u3 = gelu_tanh(bfhi(uw.y));
                            v2u o; o.x = pk2(u0 * (acc.x + bs), u1 * (acc.y + bs)); o.y = pk2(u2 * (acc.z + bs), u3 * (acc.w + bs));
                            *(v2u*)(yp + 16 * t) = o;
                        }
                    }
                    __syncthreads();
                }
                for (int i = gtid; i < M * 128; i += GT) {
                    const int row = i >> 7, c8 = (i & 127) * 8, tpos = row & (SEQ - 1);
                    const bf16* zr = Z + (size_t)row * AB_IN;
                    const v4u bg = *(const v4u*)(zr + 2048 + c8);
                    float zc[3][8];
#pragma unroll
                    for (int k = 0; k < 3; ++k) {
                        if (tpos - k >= 0) { const v4u cg = *(const v4u*)(zr - (size_t)k * AB_IN + 3072 + c8), hh = *(const v4u*)(zr - (size_t)k * AB_IN + 4096 + c8);
                            const unsigned cgw[4] = {cg.x, cg.y, cg.z, cg.w}, hw[4] = {hh.x, hh.y, hh.z, hh.w};
#pragma unroll
                            for (int e = 0; e < 4; ++e) { zc[k][2 * e] = bflo(cgw[e]) * bflo(hw[e]); zc[k][2 * e + 1] = bfhi(cgw[e]) * bfhi(hw[e]); } }
                        else {
#pragma unroll
                            for (int e = 0; e < 8; ++e) zc[k][e] = 0.f; }
                    }
                    const unsigned bgw[4] = {bg.x, bg.y, bg.z, bg.w}; float y[8];
#pragma unroll
                    for (int e = 0; e < 8; ++e) { const float bgv = (e & 1) ? bfhi(bgw[e >> 1]) : bflo(bgw[e >> 1]);
                        const float conv = cw[c8 + e] * zc[2][e] + cw[1024 + c8 + e] * zc[1][e] + cw[2048 + c8 + e] * zc[0][e]; y[e] = bgv * conv; }
                    v4u o; o.x = pk2(y[0], y[1]); o.y = pk2(y[2], y[3]); o.z = pk2(y[4], y[5]); o.w = pk2(y[6], y[7]);
                    *(v4u*)(XN + (size_t)row * D + 1024 + c8) = o;
                }
            } else {
                PHASE_PTRS();
                const bf16* LAT = (const bf16*)BIG; bf16* CQN = (bf16*)(BIG + B_CQN); bf16* CKVN = (bf16*)(BIG + B_CKVN); bf16* KR = (bf16*)(BIG + B_KR);
                const float* ROPE = (const float*)(ws + WS_ROPE);
                const float* gqn = INP(15) + (size_t)eo * 512; const float* gkv = INP(16) + (size_t)eo * 256;
                for (int m = gw; m < M; m += NGW) {
                    const bf16* lp = LAT + (size_t)m * C_INP;
                    {
                        const v4u w = *(const v4u*)(lp + 8 * lane); const unsigned ww[4] = {w.x, w.y, w.z, w.w}; float f[8]; float ss = 0.f;
#pragma unroll
                        for (int e = 0; e < 4; ++e) { f[2 * e] = bflo(ww[e]); f[2 * e + 1] = bfhi(ww[e]); ss += f[2 * e] * f[2 * e] + f[2 * e + 1] * f[2 * e + 1]; }
                        const float rr = 1.0f / sqrtf(wave_sum(ss) * (1.0f / 512.0f) + RMS_EPS); const float* gp = gqn + 8 * lane;
                        v4u o; o.x = pk2(f[0] * rr * gp[0], f[1] * rr * gp[1]); o.y = pk2(f[2] * rr * gp[2], f[3] * rr * gp[3]); o.z = pk2(f[4] * rr * gp[4], f[5] * rr * gp[5]); o.w = pk2(f[6] * rr * gp[6], f[7] * rr * gp[7]);
                        *(v4u*)(CQN + (size_t)m * 512 + 8 * lane) = o;
                    }
                    {
                        const int l2 = lane & 31; const v4u w = *(const v4u*)(lp + 512 + 8 * l2); const unsigned ww[4] = {w.x, w.y, w.z, w.w}; float f[8]; float ss = 0.f;
#pragma unroll
                        for (int e = 0; e < 4; ++e) { f[2 * e] = bflo(ww[e]); f[2 * e + 1] = bfhi(ww[e]); ss += f[2 * e] * f[2 * e] + f[2 * e + 1] * f[2 * e + 1]; }
                        if (lane >= 32) ss = 0.f;
                        const float rr = 1.0f / sqrtf(wave_sum(ss) * (1.0f / 256.0f) + RMS_EPS); const float* gp = gkv + 8 * l2;
                        v4u o; o.x = pk2(f[0] * rr * gp[0], f[1] * rr * gp[1]); o.y = pk2(f[2] * rr * gp[2], f[3] * rr * gp[3]); o.z = pk2(f[4] * rr * gp[4], f[5] * rr * gp[5]); o.w = pk2(f[6] * rr * gp[6], f[7] * rr * gp[7]);
                        if (lane < 32) *(v4u*)(CKVN + (size_t)m * 256 + 8 * l2) = o;
                    }
                    if (lane < 4) {
                        const v4u w1 = *(const v4u*)(lp + 768 + 8 * lane), w2 = *(const v4u*)(lp + 800 + 8 * lane);
                        const unsigned a1[4] = {w1.x, w1.y, w1.z, w1.w}, a2[4] = {w2.x, w2.y, w2.z, w2.w};
                        const float* rp = ROPE + (size_t)m * 64 + 8 * lane; float o1[8], o2[8];
#pragma unroll
                        for (int e = 0; e < 8; ++e) { const float xa = (e & 1) ? bfhi(a1[e >> 1]) : bflo(a1[e >> 1]), xb = (e & 1) ? bfhi(a2[e >> 1]) : bflo(a2[e >> 1]);
                            const float cc = rp[e], sn = rp[32 + e]; o1[e] = xa * cc - xb * sn; o2[e] = xb * cc + xa * sn; }
                        v4u q1, q2; q1.x = pk2(o1[0], o1[1]); q1.y = pk2(o1[2], o1[3]); q1.z = pk2(o1[4], o1[5]); q1.w = pk2(o1[6], o1[7]);
                        q2.x = pk2(o2[0], o2[1]); q2.y = pk2(o2[2], o2[3]); q2.z = pk2(o2[4], o2[5]); q2.w = pk2(o2[6], o2[7]);
                        *(v4u*)(KR + (size_t)m * 64 + 8 * lane) = q1; *(v4u*)(KR + (size_t)m * 64 + 32 + 8 * lane) = q2;
                    }
                }
            }
            __syncthreads();
            {
                PHASE_PTRS();
                pg8::Gemm g{(const bf16*)(ws + WS_KVM), (const bf16*)(W + W_WQ), 2 * D, D, 512, MMEM / 256, D / 256, 4, 1, 512, 0, 512, 0};
                pg8::Order S; S.init(g, G, cid);
                pg8::Epi<pg8::EP_BF16> E{(void*)(ws + WS_WQKT), nullptr, D, 1024, 256, 0, 0, 0, 1.f};
                pg8::gemm_phase<pg8::Epi<pg8::EP_BF16>, true>(lds + RING_OFF, g, S, E);
            }
            {
                PHASE_PTRS();
                pg8::Gemm g{(const bf16*)(W + W_WO), (const bf16*)(ws + WS_KVM) + D, D, 2 * D, 512, D / 256, 1, 4, BATCH, 512, 0, 512, (long)256 * 2 * D};
                pg8::Order S; S.init(g, G, cid);
                pg8::Epi<pg8::EP_BF16> E{(void*)(ws + WS_VWOT), nullptr, 1024, 256, 0, 2048, 256, 0, 1.f};
                pg8::gemm_phase<pg8::Epi<pg8::EP_BF16>, true>(lds + RING_OFF, g, S, E);
            }
        }
        SEAM(pb + 2);

        if (((PHM >> 3) & 1) && odd && IN(pb + 3)) {
            {
                PHASE_PTRS();
                pg8::Gemm g{(const bf16*)(BIG + B_CQN), (const bf16*)(W + W_UQ), 512, 512, 512, M / 256, 3072 / 256, 1, 1, 0, 0, 0, 0};
                pg8::Order S; S.init(g, G, cid);
                pg8::Epi<pg8::EP_BF16> E{(void*)(BIG + B_Q), nullptr, 3072, 256, 0, 0, 0, 0, 1.f};
                pg8::gemm_phase<pg8::Epi<pg8::EP_BF16>, true>(lds + RING_OFF, g, S, E);
            }
            {
                PHASE_PTRS();
                pg8::Gemm g{(const bf16*)(BIG + B_CKVN), (const bf16*)(W + W_UK), 256, 256, 256, M / 256, 2048 / 256, 1, 1, 0, 0, 0, 0};
                pg8::Order S; S.init(g, G, cid);
                pg8::Epi<pg8::EP_BF16> E{(void*)(BIG + B_KN), nullptr, 2048, 256, 0, 0, 0, 0, 1.f};
                pg8::gemm_phase<pg8::Epi<pg8::EP_BF16>, true>(lds + RING_OFF, g, S, E);
            }
            {
                PHASE_PTRS();
                pg8::Gemm g{(const bf16*)(W + W_UV), (const bf16*)(BIG + B_CKVN), 256, 256, 256, 2048 / 256, SEQ / 256, 1, BATCH, 0, 0, 0, (long)SEQ * 256};
                pg8::Order S; S.init(g, G, cid);
                pg8::Epi<pg8::EP_BF16> E{(void*)(BIG + B_VT), nullptr, 2048, 256, 0, 2048, 0, 0, 1.f};
                pg8::gemm_phase<pg8::Epi<pg8::EP_BF16>, true>(lds + RING_OFF, g, S, E);
            }
        }
        if (odd) SEAM(pb + 3);

        if (((PHM >> 5) & 1) && odd && IN(pb + 5)) {
            PHASE_PTRS();
            const att::T t{(const bf16*)(BIG + B_Q), (const bf16*)(BIG + B_KN), (const bf16*)(BIG + B_KR), (const bf16*)(BIG + B_VT), XN, (const float*)(ws + WS_ROPE)};
            for (int idx = cid; idx < 1024; idx += G) {
                const int bh = idx >> 2, p = idx & 3, b = bh >> 4, h = bh & 15;
                att::unit(lds + RING_OFF, t, b, h, p, tid, wave, lane);
                att::unit(lds + RING_OFF, t, b, h, 7 - p, tid, wave, lane);
            }
        }
        if (odd) SEAM(pb + 5);

        if (((PHM >> 6) & 1) && IN(pb + 6)) {
            PHASE_PTRS();
            pg8::Gemm g{XN, (const bf16*)(W + W_MIXB), D, D, D, M / 256, D / 256, 1, 1, 0, 0, 0, 0};
            pg8::Order S; S.init(g, G, cid);
            pg8::Epi<pg8::EP_RESID> E{(void*)X, (layer == 0) ? INP(0) : (const float*)X, D, 256, 0, 0, 0, 0, 1.f};
            pg8::gemm_phase<pg8::Epi<pg8::EP_RESID>, true>(lds + RING_OFF, g, S, E);
        }
        SEAM(pb + 6);

        if (((PHM >> 7) & 1) && IN(pb + 7)) { PHASE_PTRS(); norm_rows_bf16(X, INP(4) + (size_t)layer * D, XN, M, gw, NGW, lane); }
        SEAM(pb + 7);

        if (((PHM >> 8) & 1) && IN(pb + 8)) {
            PHASE_PTRS();
            pg8::Gemm g{XN, (const bf16*)(ws + WS_WQKT), D, D, D, SEQ / 256, 1024 / 256, 1, BATCH, 0, (long)SEQ * D, 0, (long)1024 * D};
            pg8::Order S; S.init(g, G, cid);
            pg8::Epi<pg8::EP_F32S> E{(void*)(BIG + B_S), nullptr, 1024, 256, 0, SEQ, 0, 0, 0.04419417382415922f};
            pg8::gemm_phase<pg8::Epi<pg8::EP_F32S>, true>(lds + RING_OFF, g, S, E);
        }
        SEAM(pb + 8);

        if (((PHM >> 9) & 1) && IN(pb + 9)) {
            PHASE_PTRS();
            const float* Sm = (const float*)(BIG + B_S); bf16* P = (bf16*)(BIG + B_P);
            for (int m = gw; m < M; m += NGW) {
#pragma unroll
                for (int hh = 0; hh < 4; ++hh) {
                    const f32x4 v = *(const f32x4*)(Sm + (size_t)m * 1024 + hh * 256 + 4 * lane);
                    const float mx = wave_max(fmaxf(fmaxf(v.x, v.y), fmaxf(v.z, v.w)));
                    const float e0 = __expf(v.x - mx), e1 = __expf(v.y - mx), e2 = __expf(v.z - mx), e3 = __expf(v.w - mx);
                    const float inv = 1.0f / wave_sum((e0 + e1) + (e2 + e3));
                    v2u o; o.x = pk2(e0 * inv, e1 * inv); o.y = pk2(e2 * inv, e3 * inv);
                    *(v2u*)(P + (size_t)m * 1024 + hh * 256 + 4 * lane) = o;
                }
            }
        }
        SEAM(pb + 9);

        if (((PHM >> 10) & 1) && IN(pb + 10)) {
            PHASE_PTRS();
            pg8::Gemm g{(const bf16*)(BIG + B_P), (const bf16*)(ws + WS_VWOT), 1024, 1024, 1024, SEQ / 256, D / 256, 1, BATCH, 0, (long)SEQ * 1024, 0, (long)D * 1024};
            pg8::Order S; S.init(g, G, cid);
            pg8::Epi<pg8::EP_RESID> E{(void*)X, X, D, 256, 0, SEQ, 0, 0, 1.f};
            pg8::gemm_phase<pg8::Epi<pg8::EP_RESID>, true>(lds + RING_OFF, g, S, E);
        }
        SEAM(pb + 10);

        if (((PHM >> 11) & 1) && IN(pb + 11)) { PHASE_PTRS(); norm_rows_bf16(X, INP(6) + (size_t)layer * D, XN, M, gw, NGW, lane); }
        SEAM(pb + 11);

        if (((PHM >> 12) & 1) && IN(pb + 12)) {
            PHASE_PTRS();
            pg8::Gemm g{XN, (const bf16*)(W + W_W1), D, D, D, M / 256, DFF / 256, 1, 1, 0, 0, 0, 0};
            pg8::Order S; S.init(g, G, cid);
            pg8::Epi<pg8::EP_RELU2> E{(void*)BIG, nullptr, DFF, 256, 0, 0, 0, 0, 1.f};
            pg8::gemm_phase<pg8::Epi<pg8::EP_RELU2>, true>(lds + RING_OFF, g, S, E);
        }
        SEAM(pb + 12);

        if (((PHM >> 13) & 1) && IN(pb + 13)) {
            PHASE_PTRS();
            pg8::Gemm g{(const bf16*)BIG, (const bf16*)(W + W_W2), DFF, DFF, DFF, M / 256, D / 256, 1, 1, 0, 0, 0, 0};
            pg8::Order S; S.init(g, G, cid);
            pg8::Epi<pg8::EP_RESID> E{(void*)X, X, D, 256, 0, 0, 0, 0, 1.f};
            pg8::gemm_phase<pg8::Epi<pg8::EP_RESID>, true>(lds + RING_OFF, g, S, E);
        }
        if (IN(pb + 13) && IN(pb + PH_PER_LAYER)) GRID_BAR();
    }

    if (((PHM >> 16) & 1) && IN(PH_FINAL)) {
        PHASE_PTRS();
        const float* gain = INP(7);
        for (int m = gw; m < M; m += NGW) {
            f32x4* xr = (f32x4*)(X + (size_t)m * D) + lane;
            f32x4 v[8]; float s = 0.f;
#pragma unroll
            for (int j = 0; j < 8; ++j) { v[j] = xr[64 * j]; s += (v[j].x * v[j].x + v[j].y * v[j].y) + (v[j].z * v[j].z + v[j].w * v[j].w); }
            const float r = 1.0f / sqrtf(wave_sum(s) * (1.0f / D) + RMS_EPS);
#pragma unroll
            for (int j = 0; j < 8; ++j) { const f32x4 gv = ((const f32x4*)gain)[lane + 64 * j]; xr[64 * j] = v[j] * r * gv; }
        }
    }
#undef IN
#undef BOTH
#undef SEAM
}

extern "C" void kernel_launch(void* const* d_in, const int* in_sizes, int n_in, void* d_out, int out_size, void* d_ws, size_t ws_size, hipStream_t stream) {
    static int grid = 0;
    if (grid == 0) {
        if (n_in != 26 || out_size != M * D || ws_size < WS_END) { fprintf(stderr, "kernel_launch: unexpected problem (n_in %d, out %d, ws %zu)\n", n_in, out_size, ws_size); grid = -1; return; }
        int dev = 0, cus = 0, per_cu = 0;
        if (hipGetDevice(&dev) != hipSuccess || hipDeviceGetAttribute(&cus, hipDeviceAttributeMultiprocessorCount, dev) != hipSuccess) { grid = -1; return; }
        if (hipFuncSetAttribute((const void*)trunk_fwd, hipFuncAttributeMaxDynamicSharedMemorySize, LDS_BYTES) != hipSuccess) { fprintf(stderr, "kernel_launch: hipFuncSetAttribute failed\n"); grid = -1; return; }
        if (hipOccupancyMaxActiveBlocksPerMultiprocessor(&per_cu, (const void*)trunk_fwd, NWAVES * 64, LDS_BYTES) != hipSuccess || per_cu < 1) { fprintf(stderr, "kernel_launch: occupancy query says %d\n", per_cu); }
        (void)hipGetLastError();
        grid = cus;
    }
    if (grid < 0) return;
    if (hipMemsetAsync((char*)d_ws + WS_CTL, 0, CTL_ZERO_BYTES, stream) != hipSuccess) return;
    Args a{};
    for (int i = 0; i < 26; ++i) a.in[i] = (const float*)d_in[i];
    a.out = (float*)d_out; a.ws = (unsigned char*)d_ws;
    for (int i = 0; i < 32; ++i) a.inv_freq[i] = (float)pow(10000.0, -(double)(2 * i) / 64.0);
#if MK_PER_PHASE
    for (int p = 0; p < PH_TOTAL; ++p) {
        const int k = p % PH_PER_LAYER, layer = p / PH_PER_LAYER;
        if (p < PH_FINAL) { if (k == 4 || k > 13) continue; if (!(layer & 1) && (k == 3 || k == 5)) continue; }
        a.ph_lo = p; a.ph_hi = p + 1;
        hipLaunchKernelGGL(trunk_fwd, dim3(grid), dim3(NWAVES * 64), LDS_BYTES, stream, a);
    }
#else
    a.ph_lo = 0; a.ph_hi = PH_TOTAL;
    hipLaunchKernelGGL(trunk_fwd, dim3(grid), dim3(NWAVES * 64), LDS_BYTES, stream, a);
#endif
}
```

```cpp
#include <hip/hip_runtime.h>
#include <cstdio>
#include <cstdint>
#include <cmath>

#ifndef PHM
#define PHM 0xFFFFF
#endif
#ifndef DBL
#define DBL 0
#endif
#ifndef MK_PER_PHASE
#define MK_PER_PHASE 0
#endif

namespace pg8 {
#define PG8_LAS __attribute__((address_space(3)))
typedef unsigned short bf16_t;
typedef short bf16x8 __attribute__((ext_vector_type(8)));
typedef float f32x4 __attribute__((ext_vector_type(4)));
typedef unsigned u32x4 __attribute__((ext_vector_type(4)));
constexpr int BM = 256, BK = 64, HALF = 128, HTB = HALF * BK * 2, STAGE_BYTES = 8 * HTB, NXCD = 8, WGM = 8;

__host__ __device__ __forceinline__ int lds_byte(int r, int c) { const int st = (r >> 4) * 2 + (c >> 5), rr = r & 15, cc = c & 31, ob = rr * 64 + cc * 2; return st * 1024 + (ob ^ (((ob >> 9) & 1) << 5)); }
__host__ __device__ __forceinline__ void stage_rc(int b, int& R, int& C) { const int st = b / 1024, sb = b % 1024, swz = sb ^ (((sb >> 9) & 1) << 5); R = (st >> 1) * 16 + swz / 64; C = (st & 1) * 32 + (swz % 64) / 2; }
__host__ __device__ __forceinline__ int perm32(int rho) { const int n = rho >> 4, i = rho & 15; return 8 * (i >> 2) + 4 * n + (i & 3); }

struct Unit { int pm, pn, z0, z1; };
struct Gemm { const bf16_t* A; const bf16_t* Bt; int lda, ldb, K, nM, nN, nZ0, nZ1; long aZ0, aZ1, bZ0, bZ1; };

struct Order {
    int nN, nwg, G, c, lgM, lgZ0, mN;
    __device__ __forceinline__ void init(const Gemm& g, int G_, int c_) { nN = g.nN; nwg = g.nM * g.nZ0 * g.nZ1 * g.nN; G = G_; c = c_;
        lgM = 31 - __builtin_clz(g.nM); lgZ0 = 31 - __builtin_clz(g.nZ0); mN = ((1 << 20) + g.nN - 1) / g.nN; }
    __device__ __forceinline__ bool next(int i, Unit& u) const {
        const int L = i * G + c; if (L >= nwg) return false;
        const int wgid = (L & 7) * (nwg >> 3) + (L >> 3);
        const int w8 = wgid >> 3, gid = (int)(((unsigned)w8 * (unsigned)mN) >> 20);
        const int gm = gid * 8 + (wgid & 7); u.pn = w8 - gid * nN;
        u.pm = gm & ((1 << lgM) - 1); const int z = gm >> lgM; u.z0 = z & ((1 << lgZ0) - 1); u.z1 = z >> lgZ0; return true;
    }
};

__device__ __forceinline__ unsigned cvt_pk_bf16(float lo, float hi) { unsigned r; asm volatile("v_cvt_pk_bf16_f32 %0, %1, %2" : "=v"(r) : "v"(lo), "v"(hi)); return r; }

enum { EP_BF16 = 0, EP_RELU2 = 1, EP_RESID = 2, EP_F32S = 3 };
__device__ __forceinline__ float bf_lo(unsigned w) { return __uint_as_float(w << 16); }
__device__ __forceinline__ float bf_hi(unsigned w) { return __uint_as_float(w & 0xffff0000u); }
template <int MODE> struct Epi {
    static constexpr bool PERM = (MODE != EP_F32S);
    void* out; float* ss; int ldc, rM, rZ0, rZ1, cZ0, cZ1; float scale;
    __device__ __forceinline__ void operator()(const f32x4 (&acc)[2][2][4][2], const Unit& u, int wr, int wc, int fr, int fq) const {
        const int row0 = u.pm * rM + u.z0 * rZ0 + u.z1 * rZ1 + wr * 64 + fr;
        const int colb = u.pn * BM + u.z0 * cZ0 + u.z1 * cZ1 + wc * 32;
        if constexpr (MODE == EP_RESID) {
            bf16_t* O = (bf16_t*)out; const int col0 = colb + 8 * fq;
            u32x4 cur[2], nxt[2];
#pragma unroll
            for (int bj = 0; bj < 2; ++bj) cur[bj] = *(const u32x4*)(O + (size_t)row0 * ldc + col0 + bj * HALF);
#pragma unroll
            for (int gi = 0; gi < 8; ++gi) { const int ai = gi >> 2, m = gi & 3; const int rowg = row0 + ai * HALF + m * 16; bf16_t* rowp = O + (size_t)rowg * ldc + col0;
                if (gi < 7) { const int a2 = (gi + 1) >> 2, m2 = (gi + 1) & 3; const bf16_t* rp2 = O + (size_t)(row0 + a2 * HALF + m2 * 16) * ldc + col0;
#pragma unroll
                    for (int bj = 0; bj < 2; ++bj) nxt[bj] = *(const u32x4*)(rp2 + bj * HALF); }
                asm volatile("" ::: "memory");
                float sq = 0.f;
#pragma unroll
                for (int bj = 0; bj < 2; ++bj) { const f32x4 v0 = acc[ai][bj][m][0], v1 = acc[ai][bj][m][1]; const u32x4 x = cur[bj];
                    u32x4 w; w.x = cvt_pk_bf16(bf_lo(x.x) + v0[0] * scale, bf_hi(x.x) + v0[1] * scale); w.y = cvt_pk_bf16(bf_lo(x.y) + v0[2] * scale, bf_hi(x.y) + v0[3] * scale);
                    w.z = cvt_pk_bf16(bf_lo(x.z) + v1[0] * scale, bf_hi(x.z) + v1[1] * scale); w.w = cvt_pk_bf16(bf_lo(x.w) + v1[2] * scale, bf_hi(x.w) + v1[3] * scale);
                    *(u32x4*)(rowp + bj * HALF) = w;
                    sq += (bf_lo(w.x) * bf_lo(w.x) + bf_hi(w.x) * bf_hi(w.x)) + (bf_lo(w.y) * bf_lo(w.y) + bf_hi(w.y) * bf_hi(w.y));
                    sq += (bf_lo(w.z) * bf_lo(w.z) + bf_hi(w.z) * bf_hi(w.z)) + (bf_lo(w.w) * bf_lo(w.w) + bf_hi(w.w) * bf_hi(w.w)); }
                sq += __shfl_xor(sq, 16); sq += __shfl_xor(sq, 32);
                if (fq == 0) ss[(size_t)rowg * 32 + u.pn * 4 + wc] = sq;
                asm volatile("" ::: "memory");
#pragma unroll
                for (int bj = 0; bj < 2; ++bj) cur[bj] = nxt[bj]; }
        } else {
            float rs[2][4];
#pragma unroll
            for (int ai = 0; ai < 2; ++ai)
#pragma unroll
                for (int m = 0; m < 4; ++m) { float sv = 2048.0f;
                    if (ss) { const float* pp = ss + (size_t)(row0 + ai * HALF + m * 16) * 32 + 8 * fq; const f32x4 a = *(const f32x4*)pp, b = *(const f32x4*)(pp + 4);
                        sv = ((a[0] + a[1]) + (a[2] + a[3])) + ((b[0] + b[1]) + (b[2] + b[3])); sv += __shfl_xor(sv, 16); sv += __shfl_xor(sv, 32); }
                    rs[ai][m] = ss ? __builtin_amdgcn_rsqf(sv * (1.0f / 2048.0f) + 1e-6f) : 1.0f; }
            if constexpr (PERM) {
                bf16_t* O = (bf16_t*)out; const int col0 = colb + 8 * fq;
#pragma unroll
                for (int ai = 0; ai < 2; ++ai)
#pragma unroll
                    for (int m = 0; m < 4; ++m) { bf16_t* rowp = O + (size_t)(row0 + ai * HALF + m * 16) * ldc + col0;
#pragma unroll
                        for (int bj = 0; bj < 2; ++bj) { f32x4 v0 = acc[ai][bj][m][0] * rs[ai][m], v1 = acc[ai][bj][m][1] * rs[ai][m];
                            if constexpr (MODE == EP_RELU2) {
#pragma unroll
                                for (int j = 0; j < 4; ++j) { const float a = fmaxf(v0[j], 0.f), b = fmaxf(v1[j], 0.f); v0[j] = a * a; v1[j] = b * b; } }
                            u32x4 w; w.x = cvt_pk_bf16(v0[0], v0[1]); w.y = cvt_pk_bf16(v0[2], v0[3]); w.z = cvt_pk_bf16(v1[0], v1[1]); w.w = cvt_pk_bf16(v1[2], v1[3]);
                            *(u32x4*)(rowp + bj * HALF) = w; } }
            } else {
                float* C = (float*)out; const int col0 = colb + 4 * fq;
#pragma unroll
                for (int ai = 0; ai < 2; ++ai)
#pragma unroll
                    for (int m = 0; m < 4; ++m) { const size_t off = (size_t)(row0 + ai * HALF + m * 16) * ldc + col0; const float sc = rs[ai][m] * scale;
#pragma unroll
                        for (int bj = 0; bj < 2; ++bj)
#pragma unroll
                            for (int n = 0; n < 2; ++n) *(f32x4*)(C + off + bj * HALF + n * 16) = acc[ai][bj][m][n] * sc; }
            }
        }
    }
};

template <class EpiT, bool ALIGN_EPI>
__device__ __forceinline__ void gemm_phase(PG8_LAS unsigned char* lds, const Gemm g, const Order& S, const EpiT& E) {
    int tid = threadIdx.x; asm volatile("" : "+v"(tid));
    const int wid = __builtin_amdgcn_readfirstlane(tid >> 6), lane = tid & 63, wr = wid >> 2, wc = wid & 3, fr = lane & 15, fq = lane >> 4;
    const int K = g.K, nt = K / BK;
    unsigned voffA[2], voffB[2];
#pragma unroll
    for (int i = 0; i < 2; ++i) { int R, C; stage_rc(tid * 16 + i * 8192, R, C); const int Rb = EpiT::PERM ? ((R & ~31) + perm32(R & 31)) : R;
        voffA[i] = (unsigned)(R * g.lda + C) * 2u; voffB[i] = (unsigned)(Rb * g.ldb + C) * 2u; }
    const size_t kstep = (size_t)(BK * 2);
    const size_t hstepA = (size_t)HALF * g.lda * 2, hstepB = (size_t)HALF * g.ldb * 2;
    const unsigned ldsw = (unsigned)wid * 1024u;
    const int aoff = lds_byte(wr * 64 + fr, fq * 8), boff = lds_byte(wc * 32 + fr, fq * 8);
#define PG8_SA(b, h) (((b) * 2 + (h)) * HTB)
#define PG8_SB(b, h) ((4 + (b) * 2 + (h)) * HTB)
#define PG8_STAGE(bufoff, gbase, voff) do { _Pragma("unroll") for (int _i = 0; _i < 2; ++_i) \
        __builtin_amdgcn_global_load_lds((const unsigned*)((const char*)(gbase) + (voff)[_i]), (PG8_LAS unsigned*)(lds + (bufoff) + ldsw + _i * 8192), 16, 0, 0); } while (0)
#define PG8_LDA(dst, b, h) do { _Pragma("unroll") for (int m = 0; m < 4; ++m) _Pragma("unroll") for (int k = 0; k < 2; ++k) dst[m][k] = *(const PG8_LAS bf16x8*)(lds + PG8_SA(b, h) + aoff + m * 2048 + k * 1024); } while (0)
#define PG8_LDB(dst, b, h) do { _Pragma("unroll") for (int n = 0; n < 2; ++n) _Pragma("unroll") for (int k = 0; k < 2; ++k) dst[n][k] = *(const PG8_LAS bf16x8*)(lds + PG8_SB(b, h) + boff + n * 2048 + k * 1024); } while (0)
#define PG8_MMA(ai, bj, At, Bt) do { __builtin_amdgcn_s_setprio(1); _Pragma("unroll") for (int m = 0; m < 4; ++m) _Pragma("unroll") for (int n = 0; n < 2; ++n) _Pragma("unroll") for (int k = 0; k < 2; ++k) \
        acc[ai][bj][m][n] = __builtin_amdgcn_mfma_f32_16x16x32_bf16(Bt[n][k], At[m][k], acc[ai][bj][m][n], 0, 0, 0); __builtin_amdgcn_s_setprio(0); } while (0)
#define PG8_WAIT_V(n) asm volatile("s_waitcnt vmcnt(" #n ")" ::: "memory")
#define PG8_WAIT_L(n) asm volatile("s_waitcnt lgkmcnt(" #n ")" ::: "memory")
#define PG8_BAR __builtin_amdgcn_s_barrier()
#define PG8_SCHED __builtin_amdgcn_sched_barrier(0)
#define PG8_TILEA(u) ((const char*)(g.A + (u).z0 * g.aZ0 + (u).z1 * g.aZ1 + (long)(u).pm * BM * g.lda))
#define PG8_TILEB(u) ((const char*)(g.Bt + (u).z0 * g.bZ0 + (u).z1 * g.bZ1 + (long)(u).pn * BM * g.ldb))
    Unit cur, nxt; int ui = 0;
    if (!S.next(0, cur)) return;
    f32x4 acc[2][2][4][2];
#pragma unroll
    for (int a = 0; a < 2; ++a)
#pragma unroll
        for (int b = 0; b < 2; ++b)
#pragma unroll
            for (int m = 0; m < 4; ++m)
#pragma unroll
                for (int n = 0; n < 2; ++n) acc[a][b][m][n] = (f32x4){0.f, 0.f, 0.f, 0.f};
    bf16x8 At[4][2], B0[2][2], B1[2][2];
    const char* cA = PG8_TILEA(cur); const char* cB = PG8_TILEB(cur);
    PG8_STAGE(PG8_SB(0, 0), cB, voffB); PG8_STAGE(PG8_SB(0, 1), cB + hstepB, voffB); PG8_STAGE(PG8_SA(0, 0), cA, voffA); PG8_STAGE(PG8_SA(0, 1), cA + hstepA, voffA);
    if (wr == 1) PG8_BAR;
    PG8_WAIT_V(2); PG8_BAR;
    PG8_STAGE(PG8_SB(1, 0), cB + kstep, voffB); PG8_STAGE(PG8_SA(1, 0), cA + kstep, voffA); PG8_STAGE(PG8_SB(1, 1), cB + hstepB + kstep, voffB);
    PG8_WAIT_V(6); PG8_BAR;
    for (;;) {
        const bool has_next = S.next(ui + 1, nxt);
        const char* nA = has_next ? PG8_TILEA(nxt) : cA; const char* nB = has_next ? PG8_TILEB(nxt) : cB;
        for (int t = 0; t < nt; t += 2) {
            const bool last = (t == nt - 2);
            const char* a1 = cA + (size_t)(t + 1) * kstep;
            const char* a2 = last ? nA : cA + (size_t)(t + 2) * kstep; const char* b2 = last ? nB : cB + (size_t)(t + 2) * kstep;
            const char* a3 = a2 + kstep; const char* b3 = b2 + kstep;
            PG8_LDB(B0, 0, 0); PG8_LDB(B1, 0, 1); PG8_SCHED; PG8_LDA(At, 0, 0); PG8_STAGE(PG8_SA(1, 1), a1 + hstepA, voffA);
            PG8_WAIT_V(8); PG8_WAIT_L(0); PG8_BAR; PG8_MMA(0, 0, At, B0); PG8_MMA(0, 1, At, B1); PG8_BAR; PG8_SCHED;
            PG8_LDA(At, 0, 1); PG8_STAGE(PG8_SB(0, 0), b2, voffB); PG8_STAGE(PG8_SB(0, 1), b2 + hstepB, voffB); PG8_STAGE(PG8_SA(0, 0), a2, voffA);
            PG8_WAIT_V(8); PG8_WAIT_L(0); PG8_BAR; PG8_MMA(1, 0, At, B0); PG8_MMA(1, 1, At, B1); PG8_BAR; PG8_SCHED;
            PG8_LDB(B0, 1, 0); PG8_LDB(B1, 1, 1); PG8_SCHED; PG8_LDA(At, 1, 0); PG8_STAGE(PG8_SA(0, 1), a2 + hstepA, voffA);
            PG8_WAIT_V(8); PG8_WAIT_L(0); PG8_BAR; PG8_MMA(0, 0, At, B0); PG8_MMA(0, 1, At, B1); PG8_BAR; PG8_SCHED;
            PG8_LDA(At, 1, 1); PG8_STAGE(PG8_SB(1, 0), b3, voffB); PG8_STAGE(PG8_SB(1, 1), b3 + hstepB, voffB); PG8_STAGE(PG8_SA(1, 0), a3, voffA);
            PG8_WAIT_V(8); PG8_WAIT_L(0); PG8_BAR; PG8_MMA(1, 0, At, B0); PG8_MMA(1, 1, At, B1); PG8_BAR; PG8_SCHED;
        }
        if constexpr (ALIGN_EPI) { if (wr == 0) PG8_BAR; }
        E(acc, cur, wr, wc, fr, fq);
        if (!has_next) break;
#pragma unroll
        for (int a = 0; a < 2; ++a)
#pragma unroll
            for (int b = 0; b < 2; ++b)
#pragma unroll
                for (int m = 0; m < 4; ++m)
#pragma unroll
                    for (int n = 0; n < 2; ++n) acc[a][b][m][n] = (f32x4){0.f, 0.f, 0.f, 0.f};
        cur = nxt; cA = nA; cB = nB; ++ui;
        if constexpr (ALIGN_EPI) { if (wr == 1) PG8_BAR; }
    }
    PG8_WAIT_V(0);
    if constexpr (!ALIGN_EPI) { if (wr == 0) PG8_BAR; }
    PG8_BAR;
#undef PG8_SA
#undef PG8_SB
#undef PG8_STAGE
#undef PG8_LDA
#undef PG8_LDB
#undef PG8_MMA
#undef PG8_WAIT_V
#undef PG8_WAIT_L
#undef PG8_BAR
#undef PG8_SCHED
#undef PG8_TILEA
#undef PG8_TILEB
}
}

constexpr int NWAVES = 8;
constexpr int BATCH = 16, SEQ = 2048, D = 2048, M = BATCH * SEQ, NMEM = 256, MMEM = BATCH * NMEM, DEPTH = 4;
constexpr int AB_IN = 5120, C_IN = 832, C_INP = 1024, DFF = 8192;
constexpr float RMS_EPS = 1e-6f;

constexpr size_t MiB = 1u << 20;
constexpr size_t WS_CTL = 0, CTL_ZERO_BYTES = 1 * MiB;

constexpr size_t WS_ROPE = 8 * MiB;
constexpr size_t WS_W = 16 * MiB;
constexpr size_t W_MIXA = 0, W_UQ = 4 * MiB, W_UK = 8 * MiB, W_UV = 9 * MiB, W_MIXB = 20 * MiB, W_WQ = 28 * MiB, W_WKV = 36 * MiB, W_WO = 52 * MiB, W_W1 = 60 * MiB, W_W2 = 92 * MiB;
constexpr size_t WS_XN = 144 * MiB;
constexpr size_t WS_BIG = 272 * MiB;
constexpr size_t B_Q = 0, B_KN = 192 * MiB, B_VT = 320 * MiB, B_CQN = 448 * MiB, B_CKVN = 480 * MiB, B_KR = 496 * MiB;
constexpr size_t B_S = 0, B_P = 128 * MiB;
constexpr size_t WS_WQKT = 784 * MiB, WS_VWOT = 848 * MiB, WS_KVM = 912 * MiB, WS_MEMN = 944 * MiB, WS_WSM = 960 * MiB, WS_XB = 961 * MiB, WS_SSP = 1089 * MiB, WS_END = 1101 * MiB;
constexpr size_t SSP_SLOT = (size_t)M * 32;
constexpr int CW_TMO = 0, CW_BAR = 4096;

constexpr int RING_OFF = 0, RING_BYTES = 131072;
constexpr int LDSCTL_OFF = RING_BYTES, MISC_OFF = LDSCTL_OFF + 320;
constexpr int LDS_BYTES = 147456;
constexpr int PTAB_OFF = LDSCTL_OFF + 512;
constexpr int INVF_OFF = LDSCTL_OFF + 1024;

#define LAS __attribute__((address_space(3)))
typedef unsigned short bf16;
typedef unsigned v4u __attribute__((ext_vector_type(4)));
typedef unsigned v2u __attribute__((ext_vector_type(2)));
typedef float f32x4 __attribute__((ext_vector_type(4)));
typedef short bf16x8 __attribute__((ext_vector_type(8)));
typedef short s16x4 __attribute__((ext_vector_type(4)));
#define LDS_WAIT() asm volatile("s_waitcnt lgkmcnt(0)" ::: "memory")

__device__ __forceinline__ float bf2f(unsigned short b) { return __uint_as_float(((unsigned)b) << 16); }
__device__ __forceinline__ float bflo(unsigned w) { return __uint_as_float(w << 16); }
__device__ __forceinline__ float bfhi(unsigned w) { return __uint_as_float(w & 0xffff0000u); }
__device__ __forceinline__ unsigned pk2(float lo, float hi) { return pg8::cvt_pk_bf16(lo, hi); }
__device__ __forceinline__ float gelu_tanh(float x) {
    const float y = 0.7978845608028654f * (x + 0.044715f * x * x * x);
    return x / (1.0f + __expf(-2.0f * y));
}

#define XB_TMO      128
#define XB_XCNT(j)  (256  + 64 * (j))
#define XB_XSUB(j)  (1280 + 64 * (j))
#define XB_XGEN(j)  (2304 + 64 * (j))
#define XB_TOP      3328
#define XB_TOPGEN   3392
#define XCD_BAR_WORDS 3456
#define XB_SPIN_CAP (1u << 18)
__device__ __forceinline__ unsigned xb_ld(unsigned* p)              { return __hip_atomic_load(p, __ATOMIC_RELAXED, __HIP_MEMORY_SCOPE_AGENT); }
__device__ __forceinline__ unsigned xb_add(unsigned* p, unsigned v) { return __hip_atomic_fetch_add(p, v, __ATOMIC_RELAXED, __HIP_MEMORY_SCOPE_AGENT); }
__device__ __forceinline__ unsigned xb_xcc_id() { return (unsigned)__builtin_amdgcn_s_getreg((3 << 11) | 20) & 0xFu; }
#define XB_SPIN(cond, bar) do { unsigned _sp = 0; while (cond) { __builtin_amdgcn_s_sleep(1); \
    if ((++_sp & 255u) == 0u) { if (xb_ld(&(bar)[XB_TMO])) break; if (_sp > XB_SPIN_CAP) { atomicAdd(&(bar)[XB_TMO], 1u); break; } } } } while (0)
struct XcdBarrier { unsigned* bar; unsigned x; volatile LAS unsigned* st; };
__device__ __forceinline__ XcdBarrier xcd_barrier_post(unsigned* bar, volatile LAS unsigned* st) {
    XcdBarrier b; b.bar = bar; b.x = xb_xcc_id(); b.st = st;
    if (threadIdx.x == 0) (void)xb_add(&bar[XB_XCNT(b.x)], 1u);
    return b;
}
__device__ __forceinline__ void xcd_barrier_complete(unsigned* bar, unsigned x, unsigned& nloc, unsigned& nx) {
    const unsigned G = gridDim.x * gridDim.y * gridDim.z;
    unsigned sum, cnt, mine, sp = 0u;
    for (;;) {
        sum = 0u; cnt = 0u; mine = 0u;
#pragma unroll
        for (unsigned j = 0; j < 16; ++j) { const unsigned c = xb_ld(&bar[XB_XCNT(j)]); sum += c; cnt += (c > 0u) ? 1u : 0u; mine = (j == x) ? c : mine; }
        if (sum == G) break;
        __builtin_amdgcn_s_sleep(1);
        if ((++sp & 255u) == 0u) { if (xb_ld(&bar[XB_TMO])) break; if (sp > XB_SPIN_CAP) { atomicAdd(&bar[XB_TMO], 1u); break; } }
    }
    nloc = mine > 0u ? mine : 1u; nx = cnt > 0u ? cnt : 1u;
}
__device__ __forceinline__ void xcd_barrier(const XcdBarrier& b) {
    asm volatile("s_waitcnt vmcnt(0)" ::: "memory");
    __syncthreads();
    if (threadIdx.x == 0) {
        unsigned* bar = b.bar;
        __builtin_amdgcn_s_waitcnt(0);
        unsigned nloc = b.st[0], nx = b.st[1];
        if (nloc == 0u) { xcd_barrier_complete(bar, b.x, nloc, nx); b.st[0] = nloc; b.st[1] = nx; }
        const unsigned old = xb_add(&bar[XB_XSUB(b.x)], 1u);
        const unsigned gen = old / nloc;
        if (old + 1u == (gen + 1u) * nloc) {
            __builtin_amdgcn_fence(__ATOMIC_RELEASE, "agent");
            asm volatile("s_waitcnt vmcnt(0)" ::: "memory");
            const unsigned og = xb_add(&bar[XB_TOP], 1u);
            const unsigned tg = og / nx;
            if (og + 1u == (tg + 1u) * nx) xb_add(&bar[XB_TOPGEN], 1u);
            else XB_SPIN(xb_ld(&bar[XB_TOPGEN]) == tg, bar);
            __builtin_amdgcn_fence(__ATOMIC_ACQUIRE, "agent");
            xb_add(&bar[XB_XGEN(b.x)], 1u);
            asm volatile("s_waitcnt vmcnt(0)" ::: "memory");
        } else {
            XB_SPIN(xb_ld(&bar[XB_XGEN(b.x)]) == gen, bar);
            __builtin_amdgcn_fence(__ATOMIC_ACQUIRE, "agent");
            asm volatile("s_waitcnt vmcnt(0)" ::: "memory");
        }
    }
    __syncthreads();
}

__device__ __forceinline__ float wave_sum(float v) {
#pragma unroll
    for (int o = 1; o < 64; o <<= 1) v += __shfl_xor(v, o);
    return v;
}
__device__ __forceinline__ float wave_max(float v) {
#pragma unroll
    for (int o = 1; o < 64; o <<= 1) v = fmaxf(v, __shfl_xor(v, o));
    return v;
}

__device__ __forceinline__ unsigned char* ldptr(LAS unsigned char* lds, int k) {
    const volatile LAS unsigned* p = (const volatile LAS unsigned*)(lds + PTAB_OFF) + 2 * k;
    const unsigned lo = __builtin_amdgcn_readfirstlane(p[0]), hi = __builtin_amdgcn_readfirstlane(p[1]);
    return (unsigned char*)(__attribute__((address_space(1))) unsigned char*)(((unsigned long long)hi << 32) | (unsigned long long)lo);
}
template <int MODE>
__device__ __forceinline__ void transpose_item(const float* W, int K, int N, bf16* WT, bf16* WT2, int row_off, const float* gain  , LAS float* scr, int item, int lane) {
    const int nblk = N / 32, kb = item / nblk, nb = item % nblk, k0 = 64 * kb, n0 = 32 * nb;
#pragma unroll 8
    for (int i = 0; i < 32; ++i) { const int kk = 2 * i + (lane >> 5); const float gk = gain ? gain[k0 + kk] : 1.0f; scr[kk * 33 + (lane & 31)] = W[(size_t)(k0 + kk) * N + n0 + (lane & 31)] * gk; }
    LDS_WAIT(); asm volatile("" ::: "memory");
    bf16* dst = WT; int r0 = row_off + n0;
    if (MODE == 1) { const int h = n0 >> 8, w = n0 & 255; if (w < 128) { dst = WT; r0 = h * 128 + w; } else { dst = WT2; r0 = h * 128 + w - 128; } }
    const int c = lane & 7;
#pragma unroll
    for (int j = 0; j < 4; ++j) { const int n = (lane >> 3) + 8 * j; const LAS float* s = scr + (8 * c) * 33 + n;
        v4u o; o.x = pk2(s[0 * 33], s[1 * 33]); o.y = pk2(s[2 * 33], s[3 * 33]); o.z = pk2(s[4 * 33], s[5 * 33]); o.w = pk2(s[6 * 33], s[7 * 33]);
        *(v4u*)(dst + (size_t)(r0 + n) * K + k0 + 8 * c) = o; }
    LDS_WAIT(); asm volatile("" ::: "memory");
}

__device__ __forceinline__ void norm_rows_bf16(const float* X, const float* gain, bf16* out, int nrows, int gw, int NGW, int lane) {
    for (int m = gw; m < nrows; m += NGW) {
        const f32x4* xr = (const f32x4*)(X + (size_t)m * D) + lane;
        f32x4 v[8]; float s = 0.f;
#pragma unroll
        for (int j = 0; j < 8; ++j) { v[j] = xr[64 * j]; s += (v[j].x * v[j].x + v[j].y * v[j].y) + (v[j].z * v[j].z + v[j].w * v[j].w); }
        const float r = 1.0f / sqrtf(wave_sum(s) * (1.0f / D) + RMS_EPS);
        v2u* o8 = (v2u*)(out + (size_t)m * D) + lane;
#pragma unroll
        for (int j = 0; j < 8; ++j) { const f32x4 gv = ((const f32x4*)gain)[lane + 64 * j]; v2u w; w.x = pk2(v[j].x * r * gv.x, v[j].y * r * gv.y); w.y = pk2(v[j].z * r * gv.z, v[j].w * r * gv.w); o8[64 * j] = w; }
    }
}

namespace att {
constexpr int KT_BYTES = 64 * 384, VROW = 144, VT_BYTES = 128 * VROW, BUF = KT_BYTES + VT_BYTES;
struct T { const bf16* Q; const bf16* KN; const bf16* KR; const bf16* VT; bf16* O; const float* rope; };
constexpr float QK_SCALE = 0.07216878364870322f;
constexpr float C2 = QK_SCALE * 1.4426950408889634f;

__device__ __forceinline__ void unit(LAS unsigned char* lds, const T& t, int b, int h, int u, int tid, int wave, int lane) {
    const int r = lane & 15, g = lane >> 4;
    const int q0 = 256 * u + 32 * wave, cq = q0 >> 6, ntiles = 4 * u + 4;
    const size_t rowb = (size_t)b * SEQ;
    bf16x8 qf[2][6];
#pragma unroll
    for (int qs = 0; qs < 2; ++qs) {
        const bf16* qp = t.Q + (rowb + q0 + 16 * qs + r) * 3072 + h * 192 + 8 * g;
#pragma unroll
        for (int s = 0; s < 6; ++s) qf[qs][s] = *(const bf16x8*)(qp + 32 * s);
        const float* rp = t.rope + (rowb + q0 + 16 * qs + r) * 64 + 8 * g;
        const f32x4 c0 = *(const f32x4*)rp, c1 = *(const f32x4*)(rp + 4), s0 = *(const f32x4*)(rp + 32), s1 = *(const f32x4*)(rp + 36);
        const float cs[8] = {c0.x, c0.y, c0.z, c0.w, c1.x, c1.y, c1.z, c1.w}, sn[8] = {s0.x, s0.y, s0.z, s0.w, s1.x, s1.y, s1.z, s1.w};
        bf16x8 x1 = qf[qs][4], x2 = qf[qs][5]; float o1[8], o2[8];
#pragma unroll
        for (int e = 0; e < 8; ++e) { const float a = bf2f((unsigned short)x1[e]), bb = bf2f((unsigned short)x2[e]); o1[e] = a * cs[e] - bb * sn[e]; o2[e] = bb * cs[e] + a * sn[e]; }
        v4u w1, w2; w1.x = pk2(o1[0], o1[1]); w1.y = pk2(o1[2], o1[3]); w1.z = pk2(o1[4], o1[5]); w1.w = pk2(o1[6], o1[7]);
        w2.x = pk2(o2[0], o2[1]); w2.y = pk2(o2[2], o2[3]); w2.z = pk2(o2[4], o2[5]); w2.w = pk2(o2[6], o2[7]);
        qf[qs][4] = __builtin_bit_cast(bf16x8, w1); qf[qs][5] = __builtin_bit_cast(bf16x8, w2);
    }
    v4u kreg[3], vreg[2];
#define ATT_LOAD(jt) do { int t2 = tid; asm volatile("" : "+v"(t2)); \
        _Pragma("unroll") for (int i = 0; i < 3; ++i) { const int ch = t2 + 512 * i, key = ch / 24, c16 = ch % 24; const size_t krow = rowb + (size_t)(jt) * 64 + key; \
            const bf16* sp = (c16 < 16) ? t.KN + krow * 2048 + h * 128 + c16 * 8 : t.KR + krow * 64 + (c16 - 16) * 8; kreg[i] = *(const v4u*)sp; } \
        _Pragma("unroll") for (int i = 0; i < 2; ++i) { const int ch = t2 + 512 * i, dv = ch >> 3, c16 = ch & 7; \
            vreg[i] = *(const v4u*)(t.VT + ((size_t)b * 2048 + h * 128 + dv) * 2048 + (jt) * 64 + c16 * 8); } } while (0)
#define ATT_STORE(bo) do { int t2 = tid; asm volatile("" : "+v"(t2)); \
        _Pragma("unroll") for (int i = 0; i < 3; ++i) { const int ch = t2 + 512 * i, key = ch / 24, c16 = ch % 24; *(LAS v4u*)(lds + (bo) + key * 384 + ((c16 ^ (key & 7)) << 4)) = kreg[i]; } \
        _Pragma("unroll") for (int i = 0; i < 2; ++i) { const int ch = t2 + 512 * i, dv = ch >> 3, c16 = ch & 7; *(LAS v4u*)(lds + (bo) + KT_BYTES + dv * VROW + c16 * 16) = vreg[i]; } } while (0)
    float mrow[2] = {-1e30f, -1e30f}, lsum[2] = {0.f, 0.f};
    f32x4 oacc[8][2];
#pragma unroll
    for (int tt = 0; tt < 8; ++tt) { oacc[tt][0] = (f32x4){0.f, 0.f, 0.f, 0.f}; oacc[tt][1] = (f32x4){0.f, 0.f, 0.f, 0.f}; }
    const int offE = (g ^ (r & 7)) << 4, offO = offE ^ 64;
    const int kbase = r * 384, vbase = KT_BYTES + r * VROW + 8 * g;

    ATT_LOAD(0); ATT_STORE(0);
    __syncthreads();
    for (int jt = 0; jt < ntiles; ++jt) {
        const int bo = (jt & 1) * BUF, bn = ((jt + 1) & 1) * BUF;
        const bool more = (jt + 1 < ntiles);
        if (more) ATT_LOAD(jt + 1);
        if (jt <= cq) {
            f32x4 sc[4][2];
#pragma unroll
            for (int kt = 0; kt < 4; ++kt) { sc[kt][0] = (f32x4){0.f, 0.f, 0.f, 0.f}; sc[kt][1] = (f32x4){0.f, 0.f, 0.f, 0.f}; }
#pragma unroll
            for (int kt = 0; kt < 4; ++kt)
#pragma unroll
                for (int s = 0; s < 6; ++s) {
                    const bf16x8 kf = *(const LAS bf16x8*)(lds + bo + kbase + kt * (16 * 384) + (s >> 1) * 128 + ((s & 1) ? offO : offE));
                    sc[kt][0] = __builtin_amdgcn_mfma_f32_16x16x32_bf16(kf, qf[0][s], sc[kt][0], 0, 0, 0);
                    sc[kt][1] = __builtin_amdgcn_mfma_f32_16x16x32_bf16(kf, qf[1][s], sc[kt][1], 0, 0, 0);
                }
            bf16x8 pf[2][2];
#pragma unroll
            for (int qs = 0; qs < 2; ++qs) {
                float mx = sc[0][qs][0];
#pragma unroll
                for (int kt = 0; kt < 4; ++kt)
#pragma unroll
                    for (int j = 0; j < 4; ++j) mx = fmaxf(mx, sc[kt][qs][j]);
                mx = fmaxf(mx, __shfl_xor(mx, 16)); mx = fmaxf(mx, __shfl_xor(mx, 32));
                const float mnew = fmaxf(mrow[qs], mx), alpha = __builtin_amdgcn_exp2f((mrow[qs] - mnew) * C2), mc = mnew * C2;
                mrow[qs] = mnew;
                float ps = 0.f; float p[4][4];
#pragma unroll
                for (int kt = 0; kt < 4; ++kt)
#pragma unroll
                    for (int j = 0; j < 4; ++j) { p[kt][j] = __builtin_amdgcn_exp2f(sc[kt][qs][j] * C2 - mc); ps += p[kt][j]; }
                lsum[qs] = lsum[qs] * alpha + ps;
#pragma unroll
                for (int s2 = 0; s2 < 2; ++s2) { v4u w; w.x = pk2(p[2 * s2][0], p[2 * s2][1]); w.y = pk2(p[2 * s2][2], p[2 * s2][3]); w.z = pk2(p[2 * s2 + 1][0], p[2 * s2 + 1][1]); w.w = pk2(p[2 * s2 + 1][2], p[2 * s2 + 1][3]);
                    pf[qs][s2] = __builtin_bit_cast(bf16x8, w); }
#pragma unroll
                for (int tt = 0; tt < 8; ++tt) oacc[tt][qs] = oacc[tt][qs] * alpha;
            }
#pragma unroll
            for (int tt = 0; tt < 8; ++tt)
#pragma unroll
                for (int s2 = 0; s2 < 2; ++s2) {
                    const v2u lo = *(const LAS v2u*)(lds + bo + vbase + tt * (16 * VROW) + s2 * 64);
                    const v2u hi = *(const LAS v2u*)(lds + bo + vbase + tt * (16 * VROW) + s2 * 64 + 32);
                    const v4u vv = {lo.x, lo.y, hi.x, hi.y}; const bf16x8 vf = __builtin_bit_cast(bf16x8, vv);
                    oacc[tt][0] = __builtin_amdgcn_mfma_f32_16x16x32_bf16(vf, pf[0][s2], oacc[tt][0], 0, 0, 0);
                    oacc[tt][1] = __builtin_amdgcn_mfma_f32_16x16x32_bf16(vf, pf[1][s2], oacc[tt][1], 0, 0, 0);
                }
        }
        if (more) ATT_STORE(bn);
        __syncthreads();
    }
#undef ATT_LOAD
#undef ATT_STORE
#pragma unroll
    for (int qs = 0; qs < 2; ++qs) {
        float l = lsum[qs]; l += __shfl_xor(l, 16); l += __shfl_xor(l, 32);
        const float inv = 1.0f / l;
        bf16* op = t.O + (rowb + q0 + 16 * qs + r) * 2048 + h * 128 + 4 * g;
#pragma unroll
        for (int tt = 0; tt < 8; ++tt) { const f32x4 o = oacc[tt][qs] * inv; v2u w; w.x = pk2(o.x, o.y); w.y = pk2(o.z, o.w); *(v2u*)(op + 16 * tt) = w; }
    }
}
}

struct Args {
    const float* in[26]; float* out; unsigned char* ws; int ph_lo, ph_hi; float inv_freq[32];
};
constexpr int PH_PER_LAYER = 16, PH_FINAL = DEPTH * PH_PER_LAYER, PH_TOTAL = PH_FINAL + 1;

__global__ void __launch_bounds__(NWAVES * 64, 2) trunk_fwd(Args args) {
    extern __shared__ __attribute__((aligned(16))) unsigned char lds_raw[];
    LAS unsigned char* lds = (LAS unsigned char*)lds_raw;
    volatile LAS unsigned* MISC = (volatile LAS unsigned*)(lds + MISC_OFF);
    const int wave = __builtin_amdgcn_readfirstlane((int)threadIdx.x >> 6);
    const int G = gridDim.x, cid = blockIdx.x;
    const int gw = cid * NWAVES + wave, NGW = G * NWAVES, GT = G * NWAVES * 64;
    for (int u = threadIdx.x; u < (LDS_BYTES - LDSCTL_OFF) / 4; u += NWAVES * 64) ((LAS unsigned*)(lds + LDSCTL_OFF))[u] = 0u;
    __syncthreads();
    if (threadIdx.x == 0) {
        LAS unsigned long long* pt = (LAS unsigned long long*)(lds + PTAB_OFF);
#pragma unroll
        for (int k = 0; k < 26; ++k) pt[k] = (unsigned long long)args.in[k];
        pt[26] = (unsigned long long)args.out; pt[27] = (unsigned long long)args.ws;
        LAS float* fv = (LAS float*)(lds + INVF_OFF);
#pragma unroll
        for (int k = 0; k < 32; ++k) fv[k] = args.inv_freq[k];
    }
    __syncthreads();
#if MK_PER_PHASE
#define GRID_BAR() do { } while (0)
#else
    (void)xcd_barrier_post((unsigned*)(args.ws + WS_CTL) + CW_BAR, MISC + 8);
#define GRID_BAR() do { XcdBarrier b_; b_.bar = (unsigned*)(ldptr(lds, 27) + WS_CTL) + CW_BAR; unsigned x_ = xb_xcc_id(); asm volatile("" : "+s"(x_)); b_.x = x_; b_.st = MISC + 8; xcd_barrier(b_); } while (0)
#endif
    const int lo = args.ph_lo, hi = args.ph_hi;
#define IN(k) (lo <= (k) && (k) < hi)
#define BOTH(k) (IN(k) && IN((k) + 1))
#define SEAM(k) do { if (BOTH(k)) GRID_BAR(); } while (0)
#define INP(k) ((const float*)ldptr(lds, (k)))
#define PHASE_IDS() int tid = threadIdx.x; asm volatile("" : "+v"(tid)); const int lane = tid & 63, gtid = cid * (NWAVES * 64) + tid; (void)lane; (void)gtid
#define PHASE_PTRS() PHASE_IDS(); unsigned char* ws = ldptr(lds, 27); bf16* XB = (bf16*)(ws + WS_XB); float* SS = (float*)(ws + WS_SSP); unsigned char* W = ws + WS_W; bf16* XN = (bf16*)(ws + WS_XN); unsigned char* BIG = ws + WS_BIG; (void)XB; (void)SS; (void)W; (void)XN; (void)BIG

    for (int layer = 0; layer < DEPTH; ++layer) {
        const int pb = layer * PH_PER_LAYER;
        const bool odd = (layer & 1) != 0; const int eo = layer >> 1;

        if (((PHM >> 0) & 1) && IN(pb + 0)) {
            _Pragma("nounroll") for (int rep_ = 0; rep_ < ((((DBL) >> 0) & 1) ? 2 : 1); ++rep_) {
            PHASE_PTRS();
            LAS float* scr = (LAS float*)(lds + RING_OFF + wave * 16384);
            bf16* W_mixa = (bf16*)(W + W_MIXA); bf16* W_mixb = (bf16*)(W + W_MIXB); bf16* W_wkv = (bf16*)(W + W_WKV);
            int it = gw;
#define TR_JOB(MODE, Wsrc, KK, NN, DST, DST2, ROWOFF, GAIN) { const int n_items = ((KK) / 64) * ((NN) / 32); const float* gain_ = (GAIN); for (; it < n_items; it += NGW) transpose_item<MODE>((Wsrc), (KK), (NN), (DST), (DST2), (ROWOFF), gain_, scr, it, lane); it -= n_items; }
            if (!odd) {
                TR_JOB(0, INP(8) + (size_t)eo * D * AB_IN, D, AB_IN, W_mixa, W_mixa, 0, INP(3) + (size_t)layer * D);
                TR_JOB(0, INP(13) + (size_t)eo * D * D, D, D, W_mixb, W_mixb, 0, nullptr);
            } else {
                TR_JOB(0, INP(14) + (size_t)eo * D * C_IN, D, C_IN, W_mixa, W_mixa, 0, INP(3) + (size_t)layer * D);
                TR_JOB(0, INP(17) + (size_t)eo * 512 * 3072, 512, 3072, (bf16*)(W + W_UQ), (bf16*)(W + W_UQ), 0, nullptr);
                TR_JOB(1, INP(18) + (size_t)eo * 256 * 4096, 256, 4096, (bf16*)(W + W_UK), (bf16*)(W + W_UV), 0, nullptr);
                TR_JOB(0, INP(19) + (size_t)eo * D * D, D, D, W_mixb, W_mixb, 0, nullptr);
            }
            TR_JOB(0, INP(21) + (size_t)layer * D * D, D, D, W_wkv, W_wkv, 0, nullptr);
            TR_JOB(0, INP(22) + (size_t)layer * D * D, D, D, W_wkv, W_wkv, D, nullptr);
            TR_JOB(0, INP(23) + (size_t)layer * D * D, D, D, (bf16*)(W + W_WO), (bf16*)(W + W_WO), 0, nullptr);
            TR_JOB(0, INP(24) + (size_t)layer * D * DFF, D, DFF, (bf16*)(W + W_W1), (bf16*)(W + W_W1), 0, INP(6) + (size_t)layer * D);
            TR_JOB(0, INP(25) + (size_t)layer * DFF * D, DFF, D, (bf16*)(W + W_W2), (bf16*)(W + W_W2), 0, nullptr);
#undef TR_JOB
            {
                const float* wq = INP(20) + (size_t)layer * D * D; v4u* dst = (v4u*)(W + W_WQ); const float* gq = INP(4) + (size_t)layer * D;
                for (int i = gtid; i < D * D / 8; i += GT) { const f32x4 a = ((const f32x4*)wq)[2 * i], b = ((const f32x4*)wq)[2 * i + 1]; const float gk = gq[i >> 8];
                    v4u o; o.x = pk2(a.x * gk, a.y * gk); o.y = pk2(a.z * gk, a.w * gk); o.z = pk2(b.x * gk, b.y * gk); o.w = pk2(b.z * gk, b.w * gk); dst[i] = o; }
            }
            if (!odd) {
                const float* wsp = INP(10) + (size_t)eo * 8 * 128 * 128; bf16* WSM = (bf16*)(ws + WS_WSM);
                for (int i = gtid; i < 8 * 128 * 128; i += GT) { const int ii = (i >> 7) & 127, jj = i & 127; const float v = ((jj >> 6) <= (ii >> 6)) ? wsp[i] : 0.f; WSM[i] = (bf16)(pk2(v, 0.f) & 0xffffu); }
            }
            if (layer == 0) {
                const int* positions = (const int*)INP(2); float* ROPE = (float*)(ws + WS_ROPE); const LAS float* fv = (const LAS float*)(lds + INVF_OFF);
                for (int i = gtid; i < M * 32; i += GT) { const int row = i >> 5, fi = i & 31;
                    const float ang = (float)positions[row] * fv[fi];
                    const double rev = (double)ang * 0.15915494309189535; const float fr = (float)(rev - floor(rev));
                    ROPE[(size_t)row * 64 + fi] = __builtin_amdgcn_cosf(fr); ROPE[(size_t)row * 64 + 32 + fi] = __builtin_amdgcn_sinf(fr); }
            }
            norm_rows_bf16(INP(1), INP(5) + (size_t)layer * D, (bf16*)(ws + WS_MEMN), MMEM, gw, NGW, lane);
            if (layer == 0) {
                const float* xin = INP(0);
                for (int m = gw; m < M; m += NGW) {
                    const f32x4* xr = (const f32x4*)(xin + (size_t)m * D) + lane; v2u* o8 = (v2u*)(XB + (size_t)m * D) + lane; float sq = 0.f;
#pragma unroll
                    for (int j = 0; j < 8; ++j) { const f32x4 v = xr[64 * j]; v2u w; w.x = pk2(v.x, v.y); w.y = pk2(v.z, v.w); o8[64 * j] = w;
                        sq += (bflo(w.x) * bflo(w.x) + bfhi(w.x) * bfhi(w.x)) + (bflo(w.y) * bflo(w.y) + bfhi(w.y) * bfhi(w.y)); }
                    sq = wave_sum(sq); if (lane < 32) SS[2 * SSP_SLOT + (size_t)m * 32 + lane] = (lane == 0) ? sq : 0.f;
                }
            }
            __syncthreads();
        }
        }
        SEAM(pb + 0);

        if (((PHM >> 1) & 1) && IN(pb + 1)) {
            _Pragma("nounroll") for (int rep_ = 0; rep_ < ((((DBL) >> 1) & 1) ? 2 : 1); ++rep_) {
            {
                PHASE_PTRS();
                pg8::Gemm g{XB, (const bf16*)(W + W_MIXA), D, D, D, M / 256, odd ? C_INP / 256 : AB_IN / 256, 1, 1, 0, 0, 0, 0};
                pg8::Order S; S.init(g, G, cid);
                pg8::Epi<pg8::EP_BF16> E{(void*)BIG, SS + 2 * SSP_SLOT, odd ? C_INP : AB_IN, 256, 0, 0, 0, 0, 1.f};
                pg8::gemm_phase<pg8::Epi<pg8::EP_BF16>, true>(lds + RING_OFF, g, S, E);
            }
            {
                PHASE_PTRS();
                pg8::Gemm g{(const bf16*)(ws + WS_MEMN), (const bf16*)(W + W_WKV), D, D, D, MMEM / 256, 2 * D / 256, 1, 1, 0, 0, 0, 0};
                pg8::Order S; S.init(g, G, cid);
                pg8::Epi<pg8::EP_BF16> E{(void*)(ws + WS_KVM), nullptr, 2 * D, 256, 0, 0, 0, 0, 1.f};
                pg8::gemm_phase<pg8::Epi<pg8::EP_BF16>, true>(lds + RING_OFF, g, S, E);
            }
        }
        }
        SEAM(pb + 1);

        if (((PHM >> 2) & 1) && IN(pb + 2)) {
            _Pragma("nounroll") for (int rep_ = 0; rep_ < ((((DBL) >> 2) & 1) ? 2 : 1); ++rep_) {
            if (!odd) {
                PHASE_PTRS();
                const bf16* Z = (const bf16*)BIG; const bf16* WSM = (const bf16*)(ws + WS_WSM);
                const float* vng = INP(9) + (size_t)eo * 1024; const float* bsp = INP(11) + (size_t)eo * 1024; const float* cw = INP(12) + (size_t)eo * 3 * 1024;
                for (int uidx = cid; uidx < 2048; uidx += G) {
                    const int nb = uidx >> 3, gq = uidx & 7; const size_t row0 = (size_t)nb * 128;
                    {
                        const int j = tid >> 2, qd = tid & 3;
                        const v4u* vp = (const v4u*)(Z + (row0 + j) * AB_IN + 1024 + gq * 128 + qd * 32);
                        float vals[32]; float ss = 0.f;
#pragma unroll
                        for (int k4 = 0; k4 < 4; ++k4) { const v4u w = vp[k4]; const unsigned ww[4] = {w.x, w.y, w.z, w.w};
#pragma unroll
                            for (int e = 0; e < 4; ++e) { const float a = gelu_tanh(bflo(ww[e])), b = gelu_tanh(bfhi(ww[e])); vals[k4 * 8 + 2 * e] = a; vals[k4 * 8 + 2 * e + 1] = b; ss += a * a + b * b; } }
                        ss += __shfl_xor(ss, 1); ss += __shfl_xor(ss, 2);
                        const float rinv = 1.0f / sqrtf(ss * (1.0f / 128.0f) + RMS_EPS);
                        const float* gp = vng + gq * 128 + qd * 32;
                        LAS bf16* vt = (LAS bf16*)(lds + RING_OFF);
#pragma unroll
                        for (int k = 0; k < 32; ++k) vt[(qd * 32 + k) * 136 + j] = (bf16)(pk2(vals[k] * rinv * gp[k], 0.f) & 0xffffu);
                    }
                    __syncthreads();
                    {
                        const int r = lane & 15, g4 = lane >> 4; const int irow = 16 * wave + r;
                        bf16x8 wf[4];
#pragma unroll
                        for (int s = 0; s < 4; ++s) wf[s] = *(const bf16x8*)(WSM + ((size_t)(gq * 128 + irow) * 128 + 32 * s + 8 * g4));
                        const float bs = bsp[gq * 128 + irow];
                        const bf16* up = Z + (row0 + irow) * AB_IN + gq * 128 + 4 * g4;
                        bf16* yp = XN + (row0 + irow) * D + gq * 128 + 4 * g4;
#pragma unroll
                        for (int t = 0; t < 8; ++t) {
                            f32x4 acc = (f32x4){0.f, 0.f, 0.f, 0.f};
#pragma unroll
                            for (int s = 0; s < 4; ++s) { const bf16x8 vf = *(const LAS bf16x8*)(lds + RING_OFF + (16 * t + r) * 272 + (32 * s + 8 * g4) * 2);
                                acc = __builtin_amdgcn_mfma_f32_16x16x32_bf16(vf, wf[s], acc, 0, 0, 0); }
                            const v2u uw = *(const v2u*)(up + 16 * t);
                            const float u0 = gelu_tanh(bflo(uw.x)), u1 = gelu_tanh(bfhi(uw.x)), u2 = gelu_tanh(bflo(uw.y)), u3 = gelu_tanh(bfhi(uw.y));
                            v2u o; o.x = pk2(u0 * (acc.x + bs), u1 * (acc.y + bs)); o.y = pk2(u2 * (acc.z + bs), u3 * (acc.w + bs));
                            *(v2u*)(yp + 16 * t) = o;
                        }
                    }
                    __syncthreads();
                }
                for (int i = gtid; i < M * 128; i += GT) {
                    const int row = i >> 7, c8 = (i & 127) * 8, tpos = row & (SEQ - 1);
                    const bf16* zr = Z + (size_t)row * AB_IN;
                    const v4u bg = *(const v4u*)(zr + 2048 + c8);
                    float zc[3][8];
#pragma unroll
                    for (int k = 0; k < 3; ++k) {
                        if (tpos - k >= 0) { const v4u cg = *(const v4u*)(zr - (size_t)k * AB_IN + 3072 + c8), hh = *(const v4u*)(zr - (size_t)k * AB_IN + 4096 + c8);
                            const unsigned cgw[4] = {cg.x, cg.y, cg.z, cg.w}, hw[4] = {hh.x, hh.y, hh.z, hh.w};
#pragma unroll
                            for (int e = 0; e < 4; ++e) { zc[k][2 * e] = bflo(cgw[e]) * bflo(hw[e]); zc[k][2 * e + 1] = bfhi(cgw[e]) * bfhi(hw[e]); } }
                        else {
#pragma unroll
                            for (int e = 0; e < 8; ++e) zc[k][e] = 0.f; }
                    }
                    const unsigned bgw[4] = {bg.x, bg.y, bg.z, bg.w}; float y[8];
#pragma unroll
                    for (int e = 0; e < 8; ++e) { const float bgv = (e & 1) ? bfhi(bgw[e >> 1]) : bflo(bgw[e >> 1]);
                        const float conv = cw[c8 + e] * zc[2][e] + cw[1024 + c8 + e] * zc[1][e] + cw[2048 + c8 + e] * zc[0][e]; y[e] = bgv * conv; }
                    v4u o; o.x = pk2(y[0], y[1]); o.y = pk2(y[2], y[3]); o.z = pk2(y[4], y[5]); o.w = pk2(y[6], y[7]);
                    *(v4u*)(XN + (size_t)row * D + 1024 + c8) = o;
                }
            } else {
                PHASE_PTRS();
                const bf16* LAT = (const bf16*)BIG; bf16* CQN = (bf16*)(BIG + B_CQN); bf16* CKVN = (bf16*)(BIG + B_CKVN); bf16* KR = (bf16*)(BIG + B_KR);
                const float* ROPE = (const float*)(ws + WS_ROPE);
                const float* gqn = INP(15) + (size_t)eo * 512; const float* gkv = INP(16) + (size_t)eo * 256;
                for (int m = gw; m < M; m += NGW) {
                    const bf16* lp = LAT + (size_t)m * C_INP;
                    {
                        const v4u w = *(const v4u*)(lp + 8 * lane); const unsigned ww[4] = {w.x, w.y, w.z, w.w}; float f[8]; float ss = 0.f;
#pragma unroll
                        for (int e = 0; e < 4; ++e) { f[2 * e] = bflo(ww[e]); f[2 * e + 1] = bfhi(ww[e]); ss += f[2 * e] * f[2 * e] + f[2 * e + 1] * f[2 * e + 1]; }
                        const float rr = 1.0f / sqrtf(wave_sum(ss) * (1.0f / 512.0f) + RMS_EPS); const float* gp = gqn + 8 * lane;
                        v4u o; o.x = pk2(f[0] * rr * gp[0], f[1] * rr * gp[1]); o.y = pk2(f[2] * rr * gp[2], f[3] * rr * gp[3]); o.z = pk2(f[4] * rr * gp[4], f[5] * rr * gp[5]); o.w = pk2(f[6] * rr * gp[6], f[7] * rr * gp[7]);
                        *(v4u*)(CQN + (size_t)m * 512 + 8 * lane) = o;
                    }
                    {
                        const int l2 = lane & 31; const v4u w = *(const v4u*)(lp + 512 + 8 * l2); const unsigned ww[4] = {w.x, w.y, w.z, w.w}; float f[8]; float ss = 0.f;
#pragma unroll
                        for (int e = 0; e < 4; ++e) { f[2 * e] = bflo(ww[e]); f[2 * e + 1] = bfhi(ww[e]); ss += f[2 * e] * f[2 * e] + f[2 * e + 1] * f[2 * e + 1]; }
                        if (lane >= 32) ss = 0.f;
                        const float rr = 1.0f / sqrtf(wave_sum(ss) * (1.0f / 256.0f) + RMS_EPS); const float* gp = gkv + 8 * l2;
                        v4u o; o.x = pk2(f[0] * rr * gp[0], f[1] * rr * gp[1]); o.y = pk2(f[2] * rr * gp[2], f[3] * rr * gp[3]); o.z = pk2(f[4] * rr * gp[4], f[5] * rr * gp[5]); o.w = pk2(f[6] * rr * gp[6], f[7] * rr * gp[7]);
                        if (lane < 32) *(v4u*)(CKVN + (size_t)m * 256 + 8 * l2) = o;
                    }
                    if (lane < 4) {
                        const v4u w1 = *(const v4u*)(lp + 768 + 8 * lane), w2 = *(const v4u*)(lp + 800 + 8 * lane);
                        const unsigned a1[4] = {w1.x, w1.y, w1.z, w1.w}, a2[4] = {w2.x, w2.y, w2.z, w2.w};
                        const float* rp = ROPE + (size_t)m * 64 + 8 * lane; float o1[8], o2[8];
#pragma unroll
                        for (int e = 0; e < 8; ++e) { const float xa = (e & 1) ? bfhi(a1[e >> 1]) : bflo(a1[e >> 1]), xb = (e & 1) ? bfhi(a2[e >> 1]) : bflo(a2[e >> 1]);
                            const float cc = rp[e], sn = rp[32 + e]; o1[e] = xa * cc - xb * sn; o2[e] = xb * cc + xa * sn; }
                        v4u q1, q2; q1.x = pk2(o1[0], o1[1]); q1.y = pk2(o1[2], o1[3]); q1.z = pk2(o1[4], o1[5]); q1.w = pk2(o1[6], o1[7]);
                        q2.x = pk2(o2[0], o2[1]); q2.y = pk2(o2[2], o2[3]); q2.z = pk2(o2[4], o2[5]); q2.w = pk2(o2[6], o2[7]);
                        *(v4u*)(KR + (size_t)m * 64 + 8 * lane) = q1; *(v4u*)(KR + (size_t)m * 64 + 32 + 8 * lane) = q2;
                    }
                }
            }
            __syncthreads();
            {
                PHASE_PTRS();
                pg8::Gemm g{(const bf16*)(ws + WS_KVM), (const bf16*)(W + W_WQ), 2 * D, D, 512, MMEM / 256, D / 256, 4, 1, 512, 0, 512, 0};
                pg8::Order S; S.init(g, G, cid);
                pg8::Epi<pg8::EP_BF16> E{(void*)(ws + WS_WQKT), nullptr, D, 1024, 256, 0, 0, 0, 1.f};
                pg8::gemm_phase<pg8::Epi<pg8::EP_BF16>, true>(lds + RING_OFF, g, S, E);
            }
            {
                PHASE_PTRS();
                pg8::Gemm g{(const bf16*)(W + W_WO), (const bf16*)(ws + WS_KVM) + D, D, 2 * D, 512, D / 256, 1, 4, BATCH, 512, 0, 512, (long)256 * 2 * D};
                pg8::Order S; S.init(g, G, cid);
                pg8::Epi<pg8::EP_BF16> E{(void*)(ws + WS_VWOT), nullptr, 1024, 256, 0, 2048, 256, 0, 1.f};
                pg8::gemm_phase<pg8::Epi<pg8::EP_BF16>, true>(lds + RING_OFF, g, S, E);
            }
        }
        }
        SEAM(pb + 2);

        if (((PHM >> 3) & 1) && odd && IN(pb + 3)) {
            _Pragma("nounroll") for (int rep_ = 0; rep_ < ((((DBL) >> 3) & 1) ? 2 : 1); ++rep_) {
            {
                PHASE_PTRS();
                pg8::Gemm g{(const bf16*)(BIG + B_CQN), (const bf16*)(W + W_UQ), 512, 512, 512, M / 256, 3072 / 256, 1, 1, 0, 0, 0, 0};
                pg8::Order S; S.init(g, G, cid);
                pg8::Epi<pg8::EP_BF16> E{(void*)(BIG + B_Q), nullptr, 3072, 256, 0, 0, 0, 0, 1.f};
                pg8::gemm_phase<pg8::Epi<pg8::EP_BF16>, true>(lds + RING_OFF, g, S, E);
            }
            {
                PHASE_PTRS();
                pg8::Gemm g{(const bf16*)(BIG + B_CKVN), (const bf16*)(W + W_UK), 256, 256, 256, M / 256, 2048 / 256, 1, 1, 0, 0, 0, 0};
                pg8::Order S; S.init(g, G, cid);
                pg8::Epi<pg8::EP_BF16> E{(void*)(BIG + B_KN), nullptr, 2048, 256, 0, 0, 0, 0, 1.f};
                pg8::gemm_phase<pg8::Epi<pg8::EP_BF16>, true>(lds + RING_OFF, g, S, E);
            }
            {
                PHASE_PTRS();
                pg8::Gemm g{(const bf16*)(W + W_UV), (const bf16*)(BIG + B_CKVN), 256, 256, 256, 2048 / 256, SEQ / 256, 1, BATCH, 0, 0, 0, (long)SEQ * 256};
                pg8::Order S; S.init(g, G, cid);
                pg8::Epi<pg8::EP_BF16> E{(void*)(BIG + B_VT), nullptr, 2048, 256, 0, 2048, 0, 0, 1.f};
                pg8::gemm_phase<pg8::Epi<pg8::EP_BF16>, true>(lds + RING_OFF, g, S, E);
            }
        }
        }
        if (odd) SEAM(pb + 3);

        if (((PHM >> 5) & 1) && odd && IN(pb + 5)) {
            _Pragma("nounroll") for (int rep_ = 0; rep_ < ((((DBL) >> 5) & 1) ? 2 : 1); ++rep_) {
            PHASE_PTRS();
            const att::T t{(const bf16*)(BIG + B_Q), (const bf16*)(BIG + B_KN), (const bf16*)(BIG + B_KR), (const bf16*)(BIG + B_VT), XN, (const float*)(ws + WS_ROPE)};
            for (int idx = cid; idx < 1024; idx += G) {
                const int bh = idx >> 2, p = idx & 3, b = bh >> 4, h = bh & 15;
                att::unit(lds + RING_OFF, t, b, h, p, tid, wave, lane);
                att::unit(lds + RING_OFF, t, b, h, 7 - p, tid, wave, lane);
            }
        }
        }
        if (odd) SEAM(pb + 5);

        if (((PHM >> 6) & 1) && IN(pb + 6)) {
            _Pragma("nounroll") for (int rep_ = 0; rep_ < ((((DBL) >> 6) & 1) ? 2 : 1); ++rep_) {
            PHASE_PTRS();
            pg8::Gemm g{XN, (const bf16*)(W + W_MIXB), D, D, D, M / 256, D / 256, 1, 1, 0, 0, 0, 0};
            pg8::Order S; S.init(g, G, cid);
            pg8::Epi<pg8::EP_RESID> E{(void*)XB, SS + 0 * SSP_SLOT, D, 256, 0, 0, 0, 0, rep_ ? 0.f : 1.f};
            pg8::gemm_phase<pg8::Epi<pg8::EP_RESID>, true>(lds + RING_OFF, g, S, E);
        }
        }
        SEAM(pb + 6);

        if (((PHM >> 8) & 1) && IN(pb + 8)) {
            _Pragma("nounroll") for (int rep_ = 0; rep_ < ((((DBL) >> 8) & 1) ? 2 : 1); ++rep_) {
            PHASE_PTRS();
            pg8::Gemm g{XB, (const bf16*)(ws + WS_WQKT), D, D, D, SEQ / 256, 1024 / 256, 1, BATCH, 0, (long)SEQ * D, 0, (long)1024 * D};
            pg8::Order S; S.init(g, G, cid);
            pg8::Epi<pg8::EP_F32S> E{(void*)(BIG + B_S), SS + 0 * SSP_SLOT, 1024, 256, 0, SEQ, 0, 0, 0.04419417382415922f};
            pg8::gemm_phase<pg8::Epi<pg8::EP_F32S>, true>(lds + RING_OFF, g, S, E);
        }
        }
        SEAM(pb + 8);

        if (((PHM >> 9) & 1) && IN(pb + 9)) {
            _Pragma("nounroll") for (int rep_ = 0; rep_ < ((((DBL) >> 9) & 1) ? 2 : 1); ++rep_) {
            PHASE_PTRS();
            const float* Sm = (const float*)(BIG + B_S); bf16* P = (bf16*)(BIG + B_P);
            for (int m = gw; m < M; m += NGW) {
#pragma unroll
                for (int hh = 0; hh < 4; ++hh) {
                    const f32x4 v = *(const f32x4*)(Sm + (size_t)m * 1024 + hh * 256 + 4 * lane);
                    const float mx = wave_max(fmaxf(fmaxf(v.x, v.y), fmaxf(v.z, v.w)));
                    const float e0 = __expf(v.x - mx), e1 = __expf(v.y - mx), e2 = __expf(v.z - mx), e3 = __expf(v.w - mx);
                    const float inv = 1.0f / wave_sum((e0 + e1) + (e2 + e3));
                    v2u o; o.x = pk2(e0 * inv, e1 * inv); o.y = pk2(e2 * inv, e3 * inv);
                    *(v2u*)(P + (size_t)m * 1024 + hh * 256 + 4 * lane) = o;
                }
            }
        }
        }
        SEAM(pb + 9);

        if (((PHM >> 10) & 1) && IN(pb + 10)) {
            _Pragma("nounroll") for (int rep_ = 0; rep_ < ((((DBL) >> 10) & 1) ? 2 : 1); ++rep_) {
            PHASE_PTRS();
            pg8::Gemm g{(const bf16*)(BIG + B_P), (const bf16*)(ws + WS_VWOT), 1024, 1024, 1024, SEQ / 256, D / 256, 1, BATCH, 0, (long)SEQ * 1024, 0, (long)D * 1024};
            pg8::Order S; S.init(g, G, cid);
            pg8::Epi<pg8::EP_RESID> E{(void*)XB, SS + 1 * SSP_SLOT, D, 256, 0, SEQ, 0, 0, rep_ ? 0.f : 1.f};
            pg8::gemm_phase<pg8::Epi<pg8::EP_RESID>, true>(lds + RING_OFF, g, S, E);
        }
        }
        SEAM(pb + 10);

        if (((PHM >> 12) & 1) && IN(pb + 12)) {
            _Pragma("nounroll") for (int rep_ = 0; rep_ < ((((DBL) >> 12) & 1) ? 2 : 1); ++rep_) {
            PHASE_PTRS();
            pg8::Gemm g{XB, (const bf16*)(W + W_W1), D, D, D, M / 256, DFF / 256, 1, 1, 0, 0, 0, 0};
            pg8::Order S; S.init(g, G, cid);
            pg8::Epi<pg8::EP_RELU2> E{(void*)BIG, SS + 1 * SSP_SLOT, DFF, 256, 0, 0, 0, 0, 1.f};
            pg8::gemm_phase<pg8::Epi<pg8::EP_RELU2>, true>(lds + RING_OFF, g, S, E);
        }
        }
        SEAM(pb + 12);

        if (((PHM >> 13) & 1) && IN(pb + 13)) {
            _Pragma("nounroll") for (int rep_ = 0; rep_ < ((((DBL) >> 13) & 1) ? 2 : 1); ++rep_) {
            PHASE_PTRS();
            pg8::Gemm g{(const bf16*)BIG, (const bf16*)(W + W_W2), DFF, DFF, DFF, M / 256, D / 256, 1, 1, 0, 0, 0, 0};
            pg8::Order S; S.init(g, G, cid);
            pg8::Epi<pg8::EP_RESID> E{(void*)XB, SS + 2 * SSP_SLOT, D, 256, 0, 0, 0, 0, rep_ ? 0.f : 1.f};
            pg8::gemm_phase<pg8::Epi<pg8::EP_RESID>, true>(lds + RING_OFF, g, S, E);
        }
        }
        if (IN(pb + 13) && IN(pb + PH_PER_LAYER)) GRID_BAR();
    }

    if (((PHM >> 16) & 1) && IN(PH_FINAL)) {
        PHASE_PTRS();
        const float* gain = INP(7); float* OUT = (float*)ldptr(lds, 26); const float* ssl = SS + 2 * SSP_SLOT;
        for (int m = gw; m < M; m += NGW) {
            const float r = __builtin_amdgcn_rsqf(wave_sum(lane < 32 ? ssl[(size_t)m * 32 + lane] : 0.f) * (1.0f / D) + RMS_EPS);
            const v4u* xr = (const v4u*)(XB + (size_t)m * D) + lane; f32x4* orow = (f32x4*)(OUT + (size_t)m * D);
#pragma unroll
            for (int j = 0; j < 4; ++j) { const v4u w = xr[64 * j]; const int c = 8 * (lane + 64 * j);
                const f32x4 g0 = *(const f32x4*)(gain + c), g1 = *(const f32x4*)(gain + c + 4);
                orow[(c >> 2)] = (f32x4){bflo(w.x) * r * g0.x, bfhi(w.x) * r * g0.y, bflo(w.y) * r * g0.z, bfhi(w.y) * r * g0.w};
                orow[(c >> 2) + 1] = (f32x4){bflo(w.z) * r * g1.x, bfhi(w.z) * r * g1.y, bflo(w.w) * r * g1.z, bfhi(w.w) * r * g1.w}; }
        }
    }
#undef IN
#undef BOTH
#undef SEAM
}

extern "C" void kernel_launch(void* const* d_in, const int* in_sizes, int n_in, void* d_out, int out_size, void* d_ws, size_t ws_size, hipStream_t stream) {
    static int grid = 0;
    if (grid == 0) {
        if (n_in != 26 || out_size != M * D || ws_size < WS_END) { fprintf(stderr, "kernel_launch: unexpected problem (n_in %d, out %d, ws %zu)\n", n_in, out_size, ws_size); grid = -1; return; }
        int dev = 0, cus = 0, per_cu = 0;
        if (hipGetDevice(&dev) != hipSuccess || hipDeviceGetAttribute(&cus, hipDeviceAttributeMultiprocessorCount, dev) != hipSuccess) { grid = -1; return; }
        if (hipFuncSetAttribute((const void*)trunk_fwd, hipFuncAttributeMaxDynamicSharedMemorySize, LDS_BYTES) != hipSuccess) { fprintf(stderr, "kernel_launch: hipFuncSetAttribute failed\n"); grid = -1; return; }
        if (hipOccupancyMaxActiveBlocksPerMultiprocessor(&per_cu, (const void*)trunk_fwd, NWAVES * 64, LDS_BYTES) != hipSuccess || per_cu < 1) { fprintf(stderr, "kernel_launch: occupancy query says %d\n", per_cu); }
        (void)hipGetLastError();
        grid = cus;
    }
    if (grid < 0) return;
    if (hipMemsetAsync((char*)d_ws + WS_CTL, 0, CTL_ZERO_BYTES, stream) != hipSuccess) return;
    Args a{};
    for (int i = 0; i < 26; ++i) a.in[i] = (const float*)d_in[i];
    a.out = (float*)d_out; a.ws = (unsigned char*)d_ws;
    for (int i = 0; i < 32; ++i) a.inv_freq[i] = (float)pow(10000.0, -(double)(2 * i) / 64.0);
#if MK_PER_PHASE
    for (int p = 0; p < PH_TOTAL; ++p) {
        const int k = p % PH_PER_LAYER, layer = p / PH_PER_LAYER;
        if (p < PH_FINAL) { if (k == 4 || k == 7 || k == 11 || k > 13) continue; if (!(layer & 1) && (k == 3 || k == 5)) continue; }
        a.ph_lo = p; a.ph_hi = p + 1;
        hipLaunchKernelGGL(trunk_fwd, dim3(grid), dim3(NWAVES * 64), LDS_BYTES, stream, a);
    }
#else
    a.ph_lo = 0; a.ph_hi = PH_TOTAL;
    hipLaunchKernelGGL(trunk_fwd, dim3(grid), dim3(NWAVES * 64), LDS_BYTES, stream, a);
#endif
}
```

```cpp
#include <hip/hip_runtime.h>
#include <cstdio>
#include <cstdint>
#include <cmath>

#ifndef PHM
#define PHM 0xFFFFF
#endif
#ifndef DBL
#define DBL 0
#endif
#ifndef DBLK
#define DBLK 0
#endif
#ifndef STAG_FFN1
#define STAG_FFN1 0
#endif
#ifndef DBLC
#define DBLC 0
#endif
#ifndef MK_PER_PHASE
#define MK_PER_PHASE 0
#endif

namespace pg8 {
#define PG8_LAS __attribute__((address_space(3)))
typedef unsigned short bf16_t;
typedef short bf16x8 __attribute__((ext_vector_type(8)));
typedef float f32x4 __attribute__((ext_vector_type(4)));
typedef unsigned u32x4 __attribute__((ext_vector_type(4)));
constexpr int BM = 256, BK = 64, HALF = 128, HTB = HALF * BK * 2, STAGE_BYTES = 8 * HTB, NXCD = 8, WGM = 8;

__host__ __device__ __forceinline__ int lds_byte(int r, int c) { const int st = (r >> 4) * 2 + (c >> 5), rr = r & 15, cc = c & 31, ob = rr * 64 + cc * 2; return st * 1024 + (ob ^ (((ob >> 9) & 1) << 5)); }
__host__ __device__ __forceinline__ void stage_rc(int b, int& R, int& C) { const int st = b / 1024, sb = b % 1024, swz = sb ^ (((sb >> 9) & 1) << 5); R = (st >> 1) * 16 + swz / 64; C = (st & 1) * 32 + (swz % 64) / 2; }
__host__ __device__ __forceinline__ int perm32(int rho) { const int n = rho >> 4, i = rho & 15; return 8 * (i >> 2) + 4 * n + (i & 3); }

struct Unit { int pm, pn, z0, z1; };
struct Gemm { const bf16_t* A; const bf16_t* Bt; int lda, ldb, K, nM, nN, nZ0, nZ1; long aZ0, aZ1, bZ0, bZ1; };

struct Order {
    int nN, nwg, G, c, lgM, lgZ0, mN;
    __device__ __forceinline__ void init(const Gemm& g, int G_, int c_) { nN = g.nN; nwg = g.nM * g.nZ0 * g.nZ1 * g.nN; G = G_; c = c_;
        lgM = 31 - __builtin_clz(g.nM); lgZ0 = 31 - __builtin_clz(g.nZ0); mN = ((1 << 20) + g.nN - 1) / g.nN; }
    __device__ __forceinline__ bool next(int i, Unit& u) const {
        const int L = i * G + c; if (L >= nwg) return false;
        const int wgid = (L & 7) * (nwg >> 3) + (L >> 3);
        const int w8 = wgid >> 3, gid = (int)(((unsigned)w8 * (unsigned)mN) >> 20);
        const int gm = gid * 8 + (wgid & 7); u.pn = w8 - gid * nN;
        u.pm = gm & ((1 << lgM) - 1); const int z = gm >> lgM; u.z0 = z & ((1 << lgZ0) - 1); u.z1 = z >> lgZ0; return true;
    }
};

__device__ __forceinline__ unsigned cvt_pk_bf16(float lo, float hi) { unsigned r; asm volatile("v_cvt_pk_bf16_f32 %0, %1, %2" : "=v"(r) : "v"(lo), "v"(hi)); return r; }

enum { EP_BF16 = 0, EP_RELU2 = 1, EP_RESID = 2, EP_F32S = 3, EP_SOFTMAX = 4 };
__device__ __forceinline__ float bf_lo(unsigned w) { return __uint_as_float(w << 16); }
__device__ __forceinline__ float bf_hi(unsigned w) { return __uint_as_float(w & 0xffff0000u); }
__device__ __forceinline__ float xsum16(float v) { const auto r = __builtin_amdgcn_permlane16_swap(__float_as_uint(v), __float_as_uint(v), false, false); return __uint_as_float(r[0]) + __uint_as_float(r[1]); }
__device__ __forceinline__ float xsum32(float v) { const auto r = __builtin_amdgcn_permlane32_swap(__float_as_uint(v), __float_as_uint(v), false, false); return __uint_as_float(r[0]) + __uint_as_float(r[1]); }
__device__ __forceinline__ float xmax16(float v) { const auto r = __builtin_amdgcn_permlane16_swap(__float_as_uint(v), __float_as_uint(v), false, false); return fmaxf(__uint_as_float(r[0]), __uint_as_float(r[1])); }
__device__ __forceinline__ float xmax32(float v) { const auto r = __builtin_amdgcn_permlane32_swap(__float_as_uint(v), __float_as_uint(v), false, false); return fmaxf(__uint_as_float(r[0]), __uint_as_float(r[1])); }
template <int MODE> struct Epi {
    static constexpr bool PERM = (MODE != EP_F32S);
    void* out; float* ss; int ldc, rM, rZ0, rZ1, cZ0, cZ1; float scale; int skip;
    __device__ __forceinline__ void operator()(f32x4 (&acc)[2][2][4][2], const Unit& u, int wr, int wc, int fr, int fq, int tid, int& rs_key, PG8_LAS unsigned char* xlds) const {
        if (skip) { asm volatile("" :: "v"(acc[0][0][0][0]), "v"(acc[1][1][3][1])); return; }
        const int row0 = u.pm * rM + u.z0 * rZ0 + u.z1 * rZ1 + wr * 64 + fr;
        const int colb = u.pn * BM + u.z0 * cZ0 + u.z1 * cZ1 + wc * 32;
        if constexpr (MODE == EP_RESID) {
            bf16_t* O = (bf16_t*)out; const int col0 = colb + 8 * fq;
            u32x4 cur[2], nxt[2];
#pragma unroll
            for (int bj = 0; bj < 2; ++bj) cur[bj] = *(const u32x4*)(O + (size_t)row0 * ldc + col0 + bj * HALF);
#pragma unroll
            for (int gi = 0; gi < 8; ++gi) { const int ai = gi >> 2, m = gi & 3; const int rowg = row0 + ai * HALF + m * 16; bf16_t* rowp = O + (size_t)rowg * ldc + col0;
                if (gi < 7) { const int a2 = (gi + 1) >> 2, m2 = (gi + 1) & 3; const bf16_t* rp2 = O + (size_t)(row0 + a2 * HALF + m2 * 16) * ldc + col0;
#pragma unroll
                    for (int bj = 0; bj < 2; ++bj) nxt[bj] = *(const u32x4*)(rp2 + bj * HALF); }
                asm volatile("" ::: "memory");
                float sq = 0.f;
#pragma unroll
                for (int bj = 0; bj < 2; ++bj) { const f32x4 v0 = acc[ai][bj][m][0], v1 = acc[ai][bj][m][1]; const u32x4 x = cur[bj];
                    u32x4 w; w.x = cvt_pk_bf16(bf_lo(x.x) + v0[0] * scale, bf_hi(x.x) + v0[1] * scale); w.y = cvt_pk_bf16(bf_lo(x.y) + v0[2] * scale, bf_hi(x.y) + v0[3] * scale);
                    w.z = cvt_pk_bf16(bf_lo(x.z) + v1[0] * scale, bf_hi(x.z) + v1[1] * scale); w.w = cvt_pk_bf16(bf_lo(x.w) + v1[2] * scale, bf_hi(x.w) + v1[3] * scale);
                    *(u32x4*)(rowp + bj * HALF) = w;
                    sq += (bf_lo(w.x) * bf_lo(w.x) + bf_hi(w.x) * bf_hi(w.x)) + (bf_lo(w.y) * bf_lo(w.y) + bf_hi(w.y) * bf_hi(w.y));
                    sq += (bf_lo(w.z) * bf_lo(w.z) + bf_hi(w.z) * bf_hi(w.z)) + (bf_lo(w.w) * bf_lo(w.w) + bf_hi(w.w) * bf_hi(w.w)); }
                sq = xsum16(sq); sq = xsum32(sq);
                if (fq == 0) ss[(size_t)rowg * 32 + u.pn * 4 + wc] = sq;
                asm volatile("" ::: "memory");
#pragma unroll
                for (int bj = 0; bj < 2; ++bj) cur[bj] = nxt[bj]; }
        } else {
            float rs[2][4];
            if (ss) {
                PG8_LAS float* rtab = (PG8_LAS float*)xlds;
                const int key = u.pm * rM + u.z0 * rZ0 + u.z1 * rZ1;
                if (key != rs_key) { rs_key = key;
                    const float* pp = ss + (size_t)(key + (tid >> 1)) * 32 + 16 * (tid & 1);
                    const f32x4 a = *(const f32x4*)pp, b = *(const f32x4*)(pp + 4), c = *(const f32x4*)(pp + 8), d = *(const f32x4*)(pp + 12);
                    float sv = (((a[0] + a[1]) + (a[2] + a[3])) + ((b[0] + b[1]) + (b[2] + b[3]))) + (((c[0] + c[1]) + (c[2] + c[3])) + ((d[0] + d[1]) + (d[2] + d[3])));
                    sv += __shfl_xor(sv, 1);
                    if ((tid & 1) == 0) rtab[tid >> 1] = __builtin_amdgcn_rsqf(sv * (1.0f / 2048.0f) + 1e-6f);
                    asm volatile("s_waitcnt lgkmcnt(0)" ::: "memory"); __builtin_amdgcn_s_barrier(); asm volatile("" ::: "memory");
                }
#pragma unroll
                for (int ai = 0; ai < 2; ++ai)
#pragma unroll
                    for (int m = 0; m < 4; ++m) rs[ai][m] = rtab[ai * HALF + wr * 64 + m * 16 + fr];
            } else {
#pragma unroll
                for (int ai = 0; ai < 2; ++ai)
#pragma unroll
                    for (int m = 0; m < 4; ++m) rs[ai][m] = 1.0f;
            }
            if constexpr (MODE == EP_SOFTMAX) {
                PG8_LAS float* smax = (PG8_LAS float*)(xlds + 1024); PG8_LAS float* ssum = (PG8_LAS float*)(xlds + 5120);
                const float c2 = scale * 1.4426950408889634f; const int trow = wr * 64 + fr;
#pragma unroll
                for (int ai = 0; ai < 2; ++ai)
#pragma unroll
                    for (int m = 0; m < 4; ++m) { const float sc = rs[ai][m] * c2; float mx = -3.0e38f;
#pragma unroll
                        for (int bj = 0; bj < 2; ++bj)
#pragma unroll
                            for (int n = 0; n < 2; ++n) { f32x4 v = acc[ai][bj][m][n] * sc; acc[ai][bj][m][n] = v; mx = fmaxf(fmaxf(mx, fmaxf(v[0], v[1])), fmaxf(v[2], v[3])); }
                        mx = xmax16(mx); mx = xmax32(mx);
                        if (fq == 0) smax[(ai * HALF + m * 16 + trow) * 4 + wc] = mx; }
                asm volatile("s_waitcnt lgkmcnt(0)" ::: "memory"); __builtin_amdgcn_s_barrier(); asm volatile("" ::: "memory");
#pragma unroll
                for (int ai = 0; ai < 2; ++ai)
#pragma unroll
                    for (int m = 0; m < 4; ++m) { const f32x4 m4 = *(const PG8_LAS f32x4*)(smax + (ai * HALF + m * 16 + trow) * 4); const float mx = fmaxf(fmaxf(m4[0], m4[1]), fmaxf(m4[2], m4[3])); float sm = 0.f;
#pragma unroll
                        for (int bj = 0; bj < 2; ++bj)
#pragma unroll
                            for (int n = 0; n < 2; ++n) { f32x4 v = acc[ai][bj][m][n];
#pragma unroll
                                for (int j = 0; j < 4; ++j) { v[j] = __builtin_amdgcn_exp2f(v[j] - mx); sm += v[j]; }
                                acc[ai][bj][m][n] = v; }
                        sm = xsum16(sm); sm = xsum32(sm);
                        if (fq == 0) ssum[(ai * HALF + m * 16 + trow) * 4 + wc] = sm; }
                asm volatile("s_waitcnt lgkmcnt(0)" ::: "memory"); __builtin_amdgcn_s_barrier(); asm volatile("" ::: "memory");
                bf16_t* O = (bf16_t*)out; const int col0 = colb + 8 * fq;
#pragma unroll
                for (int ai = 0; ai < 2; ++ai)
#pragma unroll
                    for (int m = 0; m < 4; ++m) { const f32x4 s4 = *(const PG8_LAS f32x4*)(ssum + (ai * HALF + m * 16 + trow) * 4); const float inv = 1.0f / ((s4[0] + s4[1]) + (s4[2] + s4[3]));
                        bf16_t* rowp = O + (size_t)(row0 + ai * HALF + m * 16) * ldc + col0;
#pragma unroll
                        for (int bj = 0; bj < 2; ++bj) { const f32x4 v0 = acc[ai][bj][m][0] * inv, v1 = acc[ai][bj][m][1] * inv;
                            u32x4 w; w.x = cvt_pk_bf16(v0[0], v0[1]); w.y = cvt_pk_bf16(v0[2], v0[3]); w.z = cvt_pk_bf16(v1[0], v1[1]); w.w = cvt_pk_bf16(v1[2], v1[3]);
                            *(u32x4*)(rowp + bj * HALF) = w; } }
            } else if constexpr (PERM) {
                bf16_t* O = (bf16_t*)out; const int col0 = colb + 8 * fq;
#pragma unroll
                for (int ai = 0; ai < 2; ++ai)
#pragma unroll
                    for (int m = 0; m < 4; ++m) { bf16_t* rowp = O + (size_t)(row0 + ai * HALF + m * 16) * ldc + col0;
#pragma unroll
                        for (int bj = 0; bj < 2; ++bj) { f32x4 v0 = acc[ai][bj][m][0] * rs[ai][m], v1 = acc[ai][bj][m][1] * rs[ai][m];
                            if constexpr (MODE == EP_RELU2) {
#pragma unroll
                                for (int j = 0; j < 4; ++j) { const float a = fmaxf(v0[j], 0.f), b = fmaxf(v1[j], 0.f); v0[j] = a * a; v1[j] = b * b; } }
                            u32x4 w; w.x = cvt_pk_bf16(v0[0], v0[1]); w.y = cvt_pk_bf16(v0[2], v0[3]); w.z = cvt_pk_bf16(v1[0], v1[1]); w.w = cvt_pk_bf16(v1[2], v1[3]);
                            *(u32x4*)(rowp + bj * HALF) = w; } }
            } else {
                float* C = (float*)out; const int col0 = colb + 4 * fq;
#pragma unroll
                for (int ai = 0; ai < 2; ++ai)
#pragma unroll
                    for (int m = 0; m < 4; ++m) { const size_t off = (size_t)(row0 + ai * HALF + m * 16) * ldc + col0; const float sc = rs[ai][m] * scale;
#pragma unroll
                        for (int bj = 0; bj < 2; ++bj)
#pragma unroll
                            for (int n = 0; n < 2; ++n) *(f32x4*)(C + off + bj * HALF + n * 16) = acc[ai][bj][m][n] * sc; }
            }
        }
    }
};

template <class EpiT, bool ALIGN_EPI>
__device__ __forceinline__ void gemm_phase(PG8_LAS unsigned char* lds, const Gemm g, const Order& S, const EpiT& E, int stagger_ticks = 0, PG8_LAS unsigned char* xlds = nullptr  ) {
    if (stagger_ticks > 0) {
        const unsigned long long t0 = __builtin_amdgcn_s_memrealtime();
        while (__builtin_amdgcn_s_memrealtime() - t0 < (unsigned long long)stagger_ticks) __builtin_amdgcn_s_sleep(8);
    }
    int tid = threadIdx.x; asm volatile("" : "+v"(tid));
    const int wid = __builtin_amdgcn_readfirstlane(tid >> 6), lane = tid & 63, wr = wid >> 2, wc = wid & 3, fr = lane & 15, fq = lane >> 4;
    const int K = g.K, nt = K / BK;
    const int tmul_ = (DBLC && E.skip) ? 0 : 1;
    unsigned voffA[2], voffB[2];
#pragma unroll
    for (int i = 0; i < 2; ++i) { int R, C; stage_rc(tid * 16 + i * 8192, R, C); const int Rb = EpiT::PERM ? ((R & ~31) + perm32(R & 31)) : R;
        voffA[i] = (unsigned)(R * g.lda + C) * 2u; voffB[i] = (unsigned)(Rb * g.ldb + C) * 2u; }
    const size_t kstep = (size_t)(BK * 2);
    const size_t hstepA = (size_t)HALF * g.lda * 2, hstepB = (size_t)HALF * g.ldb * 2;
    const unsigned ldsw = (unsigned)wid * 1024u;
    const int aoff = lds_byte(wr * 64 + fr, fq * 8), boff = lds_byte(wc * 32 + fr, fq * 8);
#define PG8_SA(b, h) (((b) * 2 + (h)) * HTB)
#define PG8_SB(b, h) ((4 + (b) * 2 + (h)) * HTB)
#define PG8_STAGE(bufoff, gbase, voff) do { _Pragma("unroll") for (int _i = 0; _i < 2; ++_i) \
        __builtin_amdgcn_global_load_lds((const unsigned*)((const char*)(gbase) + (voff)[_i]), (PG8_LAS unsigned*)(lds + (bufoff) + ldsw + _i * 8192), 16, 0, 0); } while (0)
#define PG8_LDA(dst, b, h) do { _Pragma("unroll") for (int m = 0; m < 4; ++m) _Pragma("unroll") for (int k = 0; k < 2; ++k) dst[m][k] = *(const PG8_LAS bf16x8*)(lds + PG8_SA(b, h) + aoff + m * 2048 + k * 1024); } while (0)
#define PG8_LDB(dst, b, h) do { _Pragma("unroll") for (int n = 0; n < 2; ++n) _Pragma("unroll") for (int k = 0; k < 2; ++k) dst[n][k] = *(const PG8_LAS bf16x8*)(lds + PG8_SB(b, h) + boff + n * 2048 + k * 1024); } while (0)
#define PG8_MMA(ai, bj, At, Bt) do { __builtin_amdgcn_s_setprio(1); _Pragma("unroll") for (int m = 0; m < 4; ++m) _Pragma("unroll") for (int n = 0; n < 2; ++n) _Pragma("unroll") for (int k = 0; k < 2; ++k) \
        acc[ai][bj][m][n] = __builtin_amdgcn_mfma_f32_16x16x32_bf16(Bt[n][k], At[m][k], acc[ai][bj][m][n], 0, 0, 0); __builtin_amdgcn_s_setprio(0); } while (0)
#define PG8_WAIT_V(n) asm volatile("s_waitcnt vmcnt(" #n ")" ::: "memory")
#define PG8_WAIT_L(n) asm volatile("s_waitcnt lgkmcnt(" #n ")" ::: "memory")
#define PG8_BAR __builtin_amdgcn_s_barrier()
#define PG8_SCHED __builtin_amdgcn_sched_barrier(0)
#define PG8_TILEA(u) ((const char*)(g.A + (u).z0 * g.aZ0 + (u).z1 * g.aZ1 + (long)((u).pm * tmul_) * BM * g.lda))
#define PG8_TILEB(u) ((const char*)(g.Bt + (u).z0 * g.bZ0 + (u).z1 * g.bZ1 + (long)((u).pn * tmul_) * BM * g.ldb))
    Unit cur, nxt; int ui = 0;
    if (!S.next(0, cur)) return;
    f32x4 acc[2][2][4][2];
#pragma unroll
    for (int a = 0; a < 2; ++a)
#pragma unroll
        for (int b = 0; b < 2; ++b)
#pragma unroll
            for (int m = 0; m < 4; ++m)
#pragma unroll
                for (int n = 0; n < 2; ++n) acc[a][b][m][n] = (f32x4){0.f, 0.f, 0.f, 0.f};
    bf16x8 At[4][2], B0[2][2], B1[2][2];
    int rs_key = -0x7fffffff;
    const char* cA = PG8_TILEA(cur); const char* cB = PG8_TILEB(cur);
    PG8_STAGE(PG8_SB(0, 0), cB, voffB); PG8_STAGE(PG8_SB(0, 1), cB + hstepB, voffB); PG8_STAGE(PG8_SA(0, 0), cA, voffA); PG8_STAGE(PG8_SA(0, 1), cA + hstepA, voffA);
    if (wr == 1) PG8_BAR;
    PG8_WAIT_V(2); PG8_BAR;
    PG8_STAGE(PG8_SB(1, 0), cB + kstep, voffB); PG8_STAGE(PG8_SA(1, 0), cA + kstep, voffA); PG8_STAGE(PG8_SB(1, 1), cB + hstepB + kstep, voffB);
    PG8_WAIT_V(6); PG8_BAR;
    for (;;) {
        const bool has_next = S.next(ui + 1, nxt);
        const char* nA = has_next ? PG8_TILEA(nxt) : cA; const char* nB = has_next ? PG8_TILEB(nxt) : cB;
        for (int t = 0; t < nt; t += 2) {
            const bool last = (t == nt - 2);
            const char* a1 = cA + (size_t)(t + 1) * kstep;
            const char* a2 = last ? nA : cA + (size_t)(t + 2) * kstep; const char* b2 = last ? nB : cB + (size_t)(t + 2) * kstep;
            const char* a3 = a2 + kstep; const char* b3 = b2 + kstep;
            PG8_LDB(B0, 0, 0); PG8_LDB(B1, 0, 1); PG8_SCHED; PG8_LDA(At, 0, 0); PG8_STAGE(PG8_SA(1, 1), a1 + hstepA, voffA);
            PG8_WAIT_V(8); PG8_WAIT_L(0); PG8_BAR; PG8_MMA(0, 0, At, B0); PG8_MMA(0, 1, At, B1); PG8_BAR; PG8_SCHED;
            PG8_LDA(At, 0, 1); PG8_STAGE(PG8_SB(0, 0), b2, voffB); PG8_STAGE(PG8_SB(0, 1), b2 + hstepB, voffB); PG8_STAGE(PG8_SA(0, 0), a2, voffA);
            PG8_WAIT_V(8); PG8_WAIT_L(0); PG8_BAR; PG8_MMA(1, 0, At, B0); PG8_MMA(1, 1, At, B1); PG8_BAR; PG8_SCHED;
            PG8_LDB(B0, 1, 0); PG8_LDB(B1, 1, 1); PG8_SCHED; PG8_LDA(At, 1, 0); PG8_STAGE(PG8_SA(0, 1), a2 + hstepA, voffA);
            PG8_WAIT_V(8); PG8_WAIT_L(0); PG8_BAR; PG8_MMA(0, 0, At, B0); PG8_MMA(0, 1, At, B1); PG8_BAR; PG8_SCHED;
            PG8_LDA(At, 1, 1); PG8_STAGE(PG8_SB(1, 0), b3, voffB); PG8_STAGE(PG8_SB(1, 1), b3 + hstepB, voffB); PG8_STAGE(PG8_SA(1, 0), a3, voffA);
            PG8_WAIT_V(8); PG8_WAIT_L(0); PG8_BAR; PG8_MMA(1, 0, At, B0); PG8_MMA(1, 1, At, B1); PG8_BAR; PG8_SCHED;
        }
        if constexpr (ALIGN_EPI) { if (wr == 0) PG8_BAR; }
        E(acc, cur, wr, wc, fr, fq, tid, rs_key, xlds);
        if (!has_next) break;
#pragma unroll
        for (int a = 0; a < 2; ++a)
#pragma unroll
            for (int b = 0; b < 2; ++b)
#pragma unroll
                for (int m = 0; m < 4; ++m)
#pragma unroll
                    for (int n = 0; n < 2; ++n) acc[a][b][m][n] = (f32x4){0.f, 0.f, 0.f, 0.f};
        cur = nxt; cA = nA; cB = nB; ++ui;
        if constexpr (ALIGN_EPI) { if (wr == 1) PG8_BAR; }
    }
    PG8_WAIT_V(0);
    if constexpr (!ALIGN_EPI) { if (wr == 0) PG8_BAR; }
    PG8_BAR;
#undef PG8_SA
#undef PG8_SB
#undef PG8_STAGE
#undef PG8_LDA
#undef PG8_LDB
#undef PG8_MMA
#undef PG8_WAIT_V
#undef PG8_WAIT_L
#undef PG8_BAR
#undef PG8_SCHED
#undef PG8_TILEA
#undef PG8_TILEB
}
}

constexpr int NWAVES = 8;
constexpr int BATCH = 16, SEQ = 2048, D = 2048, M = BATCH * SEQ, NMEM = 256, MMEM = BATCH * NMEM, DEPTH = 4;
constexpr int AB_IN = 5120, C_IN = 832, C_INP = 1024, DFF = 8192;
constexpr float RMS_EPS = 1e-6f;

constexpr size_t MiB = 1u << 20;
constexpr size_t WS_CTL = 0, CTL_ZERO_BYTES = 1 * MiB;

constexpr size_t WS_ROPE = 8 * MiB;
constexpr size_t WS_W = 16 * MiB;
constexpr size_t W_MIXA = 0, W_UQ = 4 * MiB, W_UK = 8 * MiB, W_UV = 9 * MiB, W_MIXB = 20 * MiB, W_WQ = 28 * MiB, W_WKV = 36 * MiB, W_WO = 52 * MiB, W_W1 = 60 * MiB, W_W2 = 92 * MiB;
constexpr size_t WS_XN = 144 * MiB;
constexpr size_t WS_BIG = 272 * MiB;
constexpr size_t B_Q = 0, B_KN = 192 * MiB, B_VT = 320 * MiB, B_CQN = 448 * MiB, B_CKVN = 480 * MiB, B_KR = 496 * MiB;
constexpr size_t B_S = 0, B_P = 128 * MiB;
constexpr size_t WS_WQKT = 784 * MiB, WS_VWOT = 848 * MiB, WS_KVM = 912 * MiB, WS_MEMN = 944 * MiB, WS_WSM = 960 * MiB, WS_XB = 961 * MiB, WS_SSP = 1089 * MiB, WS_END = 1101 * MiB;
constexpr size_t SSP_SLOT = (size_t)M * 32;
constexpr int CW_TMO = 0, CW_BAR = 4096;

constexpr int RING_OFF = 0, RING_BYTES = 131072;
constexpr int LDSCTL_OFF = RING_BYTES, MISC_OFF = LDSCTL_OFF + 320;
constexpr int LDS_BYTES = 147456;
constexpr int PTAB_OFF = LDSCTL_OFF + 512;
constexpr int XLDS_OFF = LDSCTL_OFF + 2048;
constexpr int INVF_OFF = LDSCTL_OFF + 1024;

#define LAS __attribute__((address_space(3)))
typedef unsigned short bf16;
typedef unsigned v4u __attribute__((ext_vector_type(4)));
typedef unsigned v2u __attribute__((ext_vector_type(2)));
typedef float f32x4 __attribute__((ext_vector_type(4)));
typedef short bf16x8 __attribute__((ext_vector_type(8)));
typedef short s16x4 __attribute__((ext_vector_type(4)));
#define LDS_WAIT() asm volatile("s_waitcnt lgkmcnt(0)" ::: "memory")

__device__ __forceinline__ float bf2f(unsigned short b) { return __uint_as_float(((unsigned)b) << 16); }
__device__ __forceinline__ float bflo(unsigned w) { return __uint_as_float(w << 16); }
__device__ __forceinline__ float bfhi(unsigned w) { return __uint_as_float(w & 0xffff0000u); }
__device__ __forceinline__ unsigned pk2(float lo, float hi) { return pg8::cvt_pk_bf16(lo, hi); }
__device__ __forceinline__ float gelu_tanh(float x) {
    const float y = 0.7978845608028654f * (x + 0.044715f * x * x * x);
    return x / (1.0f + __expf(-2.0f * y));
}

#define XB_TMO      128
#define XB_XCNT(j)  (256  + 64 * (j))
#define XB_XSUB(j)  (1280 + 64 * (j))
#define XB_XGEN(j)  (2304 + 64 * (j))
#define XB_TOP      3328
#define XB_TOPGEN   3392
#define XCD_BAR_WORDS 3456
#define XB_SPIN_CAP (1u << 18)
__device__ __forceinline__ unsigned xb_ld(unsigned* p)              { return __hip_atomic_load(p, __ATOMIC_RELAXED, __HIP_MEMORY_SCOPE_AGENT); }
__device__ __forceinline__ unsigned xb_add(unsigned* p, unsigned v) { return __hip_atomic_fetch_add(p, v, __ATOMIC_RELAXED, __HIP_MEMORY_SCOPE_AGENT); }
__device__ __forceinline__ unsigned xb_xcc_id() { return (unsigned)__builtin_amdgcn_s_getreg((3 << 11) | 20) & 0xFu; }
#define XB_SPIN(cond, bar) do { unsigned _sp = 0; while (cond) { __builtin_amdgcn_s_sleep(1); \
    if ((++_sp & 255u) == 0u) { if (xb_ld(&(bar)[XB_TMO])) break; if (_sp > XB_SPIN_CAP) { atomicAdd(&(bar)[XB_TMO], 1u); break; } } } } while (0)
struct XcdBarrier { unsigned* bar; unsigned x; volatile LAS unsigned* st; };
__device__ __forceinline__ XcdBarrier xcd_barrier_post(unsigned* bar, volatile LAS unsigned* st) {
    XcdBarrier b; b.bar = bar; b.x = xb_xcc_id(); b.st = st;
    if (threadIdx.x == 0) (void)xb_add(&bar[XB_XCNT(b.x)], 1u);
    return b;
}
__device__ __forceinline__ void xcd_barrier_complete(unsigned* bar, unsigned x, unsigned& nloc, unsigned& nx) {
    const unsigned G = gridDim.x * gridDim.y * gridDim.z;
    unsigned sum, cnt, mine, sp = 0u;
    for (;;) {
        sum = 0u; cnt = 0u; mine = 0u;
#pragma unroll
        for (unsigned j = 0; j < 16; ++j) { const unsigned c = xb_ld(&bar[XB_XCNT(j)]); sum += c; cnt += (c > 0u) ? 1u : 0u; mine = (j == x) ? c : mine; }
        if (sum == G) break;
        __builtin_amdgcn_s_sleep(1);
        if ((++sp & 255u) == 0u) { if (xb_ld(&bar[XB_TMO])) break; if (sp > XB_SPIN_CAP) { atomicAdd(&bar[XB_TMO], 1u); break; } }
    }
    nloc = mine > 0u ? mine : 1u; nx = cnt > 0u ? cnt : 1u;
}
__device__ __forceinline__ void xcd_barrier(const XcdBarrier& b) {
    asm volatile("s_waitcnt vmcnt(0)" ::: "memory");
    __syncthreads();
    if (threadIdx.x == 0) {
        unsigned* bar = b.bar;
        __builtin_amdgcn_s_waitcnt(0);
        unsigned nloc = b.st[0], nx = b.st[1];
        if (nloc == 0u) { xcd_barrier_complete(bar, b.x, nloc, nx); b.st[0] = nloc; b.st[1] = nx; }
        const unsigned old = xb_add(&bar[XB_XSUB(b.x)], 1u);
        const unsigned gen = old / nloc;
        if (old + 1u == (gen + 1u) * nloc) {
            __builtin_amdgcn_fence(__ATOMIC_RELEASE, "agent");
            asm volatile("s_waitcnt vmcnt(0)" ::: "memory");
            const unsigned og = xb_add(&bar[XB_TOP], 1u);
            const unsigned tg = og / nx;
            if (og + 1u == (tg + 1u) * nx) xb_add(&bar[XB_TOPGEN], 1u);
            else XB_SPIN(xb_ld(&bar[XB_TOPGEN]) == tg, bar);
            __builtin_amdgcn_fence(__ATOMIC_ACQUIRE, "agent");
            xb_add(&bar[XB_XGEN(b.x)], 1u);
            asm volatile("s_waitcnt vmcnt(0)" ::: "memory");
        } else {
            XB_SPIN(xb_ld(&bar[XB_XGEN(b.x)]) == gen, bar);
            __builtin_amdgcn_fence(__ATOMIC_ACQUIRE, "agent");
            asm volatile("s_waitcnt vmcnt(0)" ::: "memory");
        }
    }
    __syncthreads();
}

__device__ __forceinline__ float wave_sum(float v) {
#pragma unroll
    for (int o = 1; o < 64; o <<= 1) v += __shfl_xor(v, o);
    return v;
}
__device__ __forceinline__ float wave_max(float v) {
#pragma unroll
    for (int o = 1; o < 64; o <<= 1) v = fmaxf(v, __shfl_xor(v, o));
    return v;
}

__device__ __forceinline__ unsigned char* ldptr(LAS unsigned char* lds, int k) {
    const volatile LAS unsigned* p = (const volatile LAS unsigned*)(lds + PTAB_OFF) + 2 * k;
    const unsigned lo = __builtin_amdgcn_readfirstlane(p[0]), hi = __builtin_amdgcn_readfirstlane(p[1]);
    return (unsigned char*)(__attribute__((address_space(1))) unsigned char*)(((unsigned long long)hi << 32) | (unsigned long long)lo);
}
template <int MODE>
__device__ __forceinline__ void transpose_item(const float* W, int K, int N, bf16* WT, bf16* WT2, int row_off, const float* gain  , LAS float* scr, int item, int lane) {
    const int nblk = N / 32, kb = item / nblk, nb = item % nblk, k0 = 64 * kb, n0 = 32 * nb;
#pragma unroll 8
    for (int i = 0; i < 32; ++i) { const int kk = 2 * i + (lane >> 5); const float gk = gain ? gain[k0 + kk] : 1.0f; scr[kk * 33 + (lane & 31)] = W[(size_t)(k0 + kk) * N + n0 + (lane & 31)] * gk; }
    LDS_WAIT(); asm volatile("" ::: "memory");
    bf16* dst = WT; int r0 = row_off + n0;
    if (MODE == 1) { const int h = n0 >> 8, w = n0 & 255; if (w < 128) { dst = WT; r0 = h * 128 + w; } else { dst = WT2; r0 = h * 128 + w - 128; } }
    const int c = lane & 7;
#pragma unroll
    for (int j = 0; j < 4; ++j) { const int n = (lane >> 3) + 8 * j; const LAS float* s = scr + (8 * c) * 33 + n;
        v4u o; o.x = pk2(s[0 * 33], s[1 * 33]); o.y = pk2(s[2 * 33], s[3 * 33]); o.z = pk2(s[4 * 33], s[5 * 33]); o.w = pk2(s[6 * 33], s[7 * 33]);
        *(v4u*)(dst + (size_t)(r0 + n) * K + k0 + 8 * c) = o; }
    LDS_WAIT(); asm volatile("" ::: "memory");
}

__device__ __forceinline__ void norm_rows_bf16(const float* X, const float* gain, bf16* out, int nrows, int gw, int NGW, int lane) {
    for (int m = gw; m < nrows; m += NGW) {
        const f32x4* xr = (const f32x4*)(X + (size_t)m * D) + lane;
        f32x4 v[8]; float s = 0.f;
#pragma unroll
        for (int j = 0; j < 8; ++j) { v[j] = xr[64 * j]; s += (v[j].x * v[j].x + v[j].y * v[j].y) + (v[j].z * v[j].z + v[j].w * v[j].w); }
        const float r = 1.0f / sqrtf(wave_sum(s) * (1.0f / D) + RMS_EPS);
        v2u* o8 = (v2u*)(out + (size_t)m * D) + lane;
#pragma unroll
        for (int j = 0; j < 8; ++j) { const f32x4 gv = ((const f32x4*)gain)[lane + 64 * j]; v2u w; w.x = pk2(v[j].x * r * gv.x, v[j].y * r * gv.y); w.y = pk2(v[j].z * r * gv.z, v[j].w * r * gv.w); o8[64 * j] = w; }
    }
}

namespace att {
constexpr int KT_BYTES = 64 * 384, VROW = 144, VT_BYTES = 128 * VROW, BUF = KT_BYTES + VT_BYTES;
struct T { const bf16* Q; const bf16* KN; const bf16* KR; const bf16* VT; bf16* O; const float* rope; };
constexpr float QK_SCALE = 0.07216878364870322f;
constexpr float C2 = QK_SCALE * 1.4426950408889634f;

__device__ __forceinline__ void unit(LAS unsigned char* lds, const T& t, int b, int h, int u, int tid, int wave, int lane) {
    const int r = lane & 15, g = lane >> 4;
    const int q0 = 256 * u + 32 * wave, cq = q0 >> 6, ntiles = 4 * u + 4;
    const size_t rowb = (size_t)b * SEQ;
    bf16x8 qf[2][6];
#pragma unroll
    for (int qs = 0; qs < 2; ++qs) {
        const bf16* qp = t.Q + (rowb + q0 + 16 * qs + r) * 3072 + h * 192 + 8 * g;
#pragma unroll
        for (int s = 0; s < 6; ++s) qf[qs][s] = *(const bf16x8*)(qp + 32 * s);
        const float* rp = t.rope + (rowb + q0 + 16 * qs + r) * 64 + 8 * g;
        const f32x4 c0 = *(const f32x4*)rp, c1 = *(const f32x4*)(rp + 4), s0 = *(const f32x4*)(rp + 32), s1 = *(const f32x4*)(rp + 36);
        const float cs[8] = {c0.x, c0.y, c0.z, c0.w, c1.x, c1.y, c1.z, c1.w}, sn[8] = {s0.x, s0.y, s0.z, s0.w, s1.x, s1.y, s1.z, s1.w};
        bf16x8 x1 = qf[qs][4], x2 = qf[qs][5]; float o1[8], o2[8];
#pragma unroll
        for (int e = 0; e < 8; ++e) { const float a = bf2f((unsigned short)x1[e]), bb = bf2f((unsigned short)x2[e]); o1[e] = a * cs[e] - bb * sn[e]; o2[e] = bb * cs[e] + a * sn[e]; }
        v4u w1, w2; w1.x = pk2(o1[0], o1[1]); w1.y = pk2(o1[2], o1[3]); w1.z = pk2(o1[4], o1[5]); w1.w = pk2(o1[6], o1[7]);
        w2.x = pk2(o2[0], o2[1]); w2.y = pk2(o2[2], o2[3]); w2.z = pk2(o2[4], o2[5]); w2.w = pk2(o2[6], o2[7]);
        qf[qs][4] = __builtin_bit_cast(bf16x8, w1); qf[qs][5] = __builtin_bit_cast(bf16x8, w2);
    }
    v4u kreg[3], vreg[2];
#define ATT_LOAD(jt) do { int t2 = tid; asm volatile("" : "+v"(t2)); \
        _Pragma("unroll") for (int i = 0; i < 3; ++i) { const int ch = t2 + 512 * i, key = ch / 24, c16 = ch % 24; const size_t krow = rowb + (size_t)(jt) * 64 + key; \
            const bf16* sp = (c16 < 16) ? t.KN + krow * 2048 + h * 128 + c16 * 8 : t.KR + krow * 64 + (c16 - 16) * 8; kreg[i] = *(const v4u*)sp; } \
        _Pragma("unroll") for (int i = 0; i < 2; ++i) { const int ch = t2 + 512 * i, dv = ch >> 3, c16 = ch & 7; \
            vreg[i] = *(const v4u*)(t.VT + ((size_t)b * 2048 + h * 128 + dv) * 2048 + (jt) * 64 + c16 * 8); } } while (0)
#define ATT_STORE(bo) do { int t2 = tid; asm volatile("" : "+v"(t2)); \
        _Pragma("unroll") for (int i = 0; i < 3; ++i) { const int ch = t2 + 512 * i, key = ch / 24, c16 = ch % 24; *(LAS v4u*)(lds + (bo) + key * 384 + ((c16 ^ (key & 7)) << 4)) = kreg[i]; } \
        _Pragma("unroll") for (int i = 0; i < 2; ++i) { const int ch = t2 + 512 * i, dv = ch >> 3, c16 = ch & 7; *(LAS v4u*)(lds + (bo) + KT_BYTES + dv * VROW + c16 * 16) = vreg[i]; } } while (0)
    float mrow[2] = {-1e30f, -1e30f}, lsum[2] = {0.f, 0.f};
    f32x4 oacc[8][2];
#pragma unroll
    for (int tt = 0; tt < 8; ++tt) { oacc[tt][0] = (f32x4){0.f, 0.f, 0.f, 0.f}; oacc[tt][1] = (f32x4){0.f, 0.f, 0.f, 0.f}; }
    const int offE = (g ^ (r & 7)) << 4, offO = offE ^ 64;
    const int kbase = r * 384, vbase = KT_BYTES + r * VROW + 8 * g;

    ATT_LOAD(0); ATT_STORE(0);
    __syncthreads();
    for (int jt = 0; jt < ntiles; ++jt) {
        const int bo = (jt & 1) * BUF, bn = ((jt + 1) & 1) * BUF;
        const bool more = (jt + 1 < ntiles);
        if (more) ATT_LOAD(jt + 1);
        if (jt <= cq) {
            f32x4 sc[4][2];
#pragma unroll
            for (int kt = 0; kt < 4; ++kt) { sc[kt][0] = (f32x4){0.f, 0.f, 0.f, 0.f}; sc[kt][1] = (f32x4){0.f, 0.f, 0.f, 0.f}; }
#pragma unroll
            for (int kt = 0; kt < 4; ++kt)
#pragma unroll
                for (int s = 0; s < 6; ++s) {
                    const bf16x8 kf = *(const LAS bf16x8*)(lds + bo + kbase + kt * (16 * 384) + (s >> 1) * 128 + ((s & 1) ? offO : offE));
                    sc[kt][0] = __builtin_amdgcn_mfma_f32_16x16x32_bf16(kf, qf[0][s], sc[kt][0], 0, 0, 0);
                    sc[kt][1] = __builtin_amdgcn_mfma_f32_16x16x32_bf16(kf, qf[1][s], sc[kt][1], 0, 0, 0);
                }
            bf16x8 pf[2][2];
#pragma unroll
            for (int qs = 0; qs < 2; ++qs) {
                float mx = sc[0][qs][0];
#pragma unroll
                for (int kt = 0; kt < 4; ++kt)
#pragma unroll
                    for (int j = 0; j < 4; ++j) mx = fmaxf(mx, sc[kt][qs][j]);
                mx = fmaxf(mx, __shfl_xor(mx, 16)); mx = fmaxf(mx, __shfl_xor(mx, 32));
                const float mnew = fmaxf(mrow[qs], mx), alpha = __builtin_amdgcn_exp2f((mrow[qs] - mnew) * C2), mc = mnew * C2;
                mrow[qs] = mnew;
                float ps = 0.f; float p[4][4];
#pragma unroll
                for (int kt = 0; kt < 4; ++kt)
#pragma unroll
                    for (int j = 0; j < 4; ++j) { p[kt][j] = __builtin_amdgcn_exp2f(sc[kt][qs][j] * C2 - mc); ps += p[kt][j]; }
                lsum[qs] = lsum[qs] * alpha + ps;
#pragma unroll
                for (int s2 = 0; s2 < 2; ++s2) { v4u w; w.x = pk2(p[2 * s2][0], p[2 * s2][1]); w.y = pk2(p[2 * s2][2], p[2 * s2][3]); w.z = pk2(p[2 * s2 + 1][0], p[2 * s2 + 1][1]); w.w = pk2(p[2 * s2 + 1][2], p[2 * s2 + 1][3]);
                    pf[qs][s2] = __builtin_bit_cast(bf16x8, w); }
#pragma unroll
                for (int tt = 0; tt < 8; ++tt) oacc[tt][qs] = oacc[tt][qs] * alpha;
            }
#pragma unroll
            for (int tt = 0; tt < 8; ++tt)
#pragma unroll
                for (int s2 = 0; s2 < 2; ++s2) {
                    const v2u lo = *(const LAS v2u*)(lds + bo + vbase + tt * (16 * VROW) + s2 * 64);
                    const v2u hi = *(const LAS v2u*)(lds + bo + vbase + tt * (16 * VROW) + s2 * 64 + 32);
                    const v4u vv = {lo.x, lo.y, hi.x, hi.y}; const bf16x8 vf = __builtin_bit_cast(bf16x8, vv);
                    oacc[tt][0] = __builtin_amdgcn_mfma_f32_16x16x32_bf16(vf, pf[0][s2], oacc[tt][0], 0, 0, 0);
                    oacc[tt][1] = __builtin_amdgcn_mfma_f32_16x16x32_bf16(vf, pf[1][s2], oacc[tt][1], 0, 0, 0);
                }
        }
        if (more) ATT_STORE(bn);
        __syncthreads();
    }
#undef ATT_LOAD
#undef ATT_STORE
#pragma unroll
    for (int qs = 0; qs < 2; ++qs) {
        float l = lsum[qs]; l += __shfl_xor(l, 16); l += __shfl_xor(l, 32);
        const float inv = 1.0f / l;
        bf16* op = t.O + (rowb + q0 + 16 * qs + r) * 2048 + h * 128 + 4 * g;
#pragma unroll
        for (int tt = 0; tt < 8; ++tt) { const f32x4 o = oacc[tt][qs] * inv; v2u w; w.x = pk2(o.x, o.y); w.y = pk2(o.z, o.w); *(v2u*)(op + 16 * tt) = w; }
    }
}
}

struct Args {
    const float* in[26]; float* out; unsigned char* ws; int ph_lo, ph_hi; float inv_freq[32];
};
constexpr int PH_PER_LAYER = 16, PH_FINAL = DEPTH * PH_PER_LAYER, PH_TOTAL = PH_FINAL + 1;

__global__ void __launch_bounds__(NWAVES * 64, 2) trunk_fwd(Args args) {
    extern __shared__ __attribute__((aligned(16))) unsigned char lds_raw[];
    LAS unsigned char* lds = (LAS unsigned char*)lds_raw;
    volatile LAS unsigned* MISC = (volatile LAS unsigned*)(lds + MISC_OFF);
    const int wave = __builtin_amdgcn_readfirstlane((int)threadIdx.x >> 6);
    const int G = gridDim.x, cid = blockIdx.x;
    const int gw = cid * NWAVES + wave, NGW = G * NWAVES, GT = G * NWAVES * 64;
    for (int u = threadIdx.x; u < (LDS_BYTES - LDSCTL_OFF) / 4; u += NWAVES * 64) ((LAS unsigned*)(lds + LDSCTL_OFF))[u] = 0u;
    __syncthreads();
    if (threadIdx.x == 0) {
        LAS unsigned long long* pt = (LAS unsigned long long*)(lds + PTAB_OFF);
#pragma unroll
        for (int k = 0; k < 26; ++k) pt[k] = (unsigned long long)args.in[k];
        pt[26] = (unsigned long long)args.out; pt[27] = (unsigned long long)args.ws;
        LAS float* fv = (LAS float*)(lds + INVF_OFF);
#pragma unroll
        for (int k = 0; k < 32; ++k) fv[k] = args.inv_freq[k];
    }
    __syncthreads();
#if MK_PER_PHASE
#define GRID_BAR() do { } while (0)
#else
    (void)xcd_barrier_post((unsigned*)(args.ws + WS_CTL) + CW_BAR, MISC + 8);
#define GRID_BAR() do { XcdBarrier b_; b_.bar = (unsigned*)(ldptr(lds, 27) + WS_CTL) + CW_BAR; unsigned x_ = xb_xcc_id(); asm volatile("" : "+s"(x_)); b_.x = x_; b_.st = MISC + 8; xcd_barrier(b_); } while (0)
#endif
    const int lo = args.ph_lo, hi = args.ph_hi;
#define IN(k) (lo <= (k) && (k) < hi)
#define BOTH(k) (IN(k) && IN((k) + 1))
#define SEAM(k) do { if (BOTH(k)) GRID_BAR(); } while (0)
#define INP(k) ((const float*)ldptr(lds, (k)))
#define PHASE_IDS() int tid = threadIdx.x; asm volatile("" : "+v"(tid)); const int lane = tid & 63, gtid = cid * (NWAVES * 64) + tid; (void)lane; (void)gtid
#define PHASE_PTRS() PHASE_IDS(); unsigned char* ws = ldptr(lds, 27); bf16* XB = (bf16*)(ws + WS_XB); float* SS = (float*)(ws + WS_SSP); unsigned char* W = ws + WS_W; bf16* XN = (bf16*)(ws + WS_XN); unsigned char* BIG = ws + WS_BIG; (void)XB; (void)SS; (void)W; (void)XN; (void)BIG

    for (int layer = 0; layer < DEPTH; ++layer) {
        const int pb = layer * PH_PER_LAYER;
        const bool odd = (layer & 1) != 0; const int eo = layer >> 1;

        if (((PHM >> 0) & 1) && IN(pb + 0)) {
            _Pragma("nounroll") for (int rep_ = 0; rep_ < ((((DBL) >> 0) & 1) ? 2 : 1); ++rep_) {
            PHASE_PTRS();
            LAS float* scr = (LAS float*)(lds + RING_OFF + wave * 16384);
            bf16* W_mixa = (bf16*)(W + W_MIXA); bf16* W_mixb = (bf16*)(W + W_MIXB); bf16* W_wkv = (bf16*)(W + W_WKV);
            int it = gw;
#define TR_JOB(MODE, Wsrc, KK, NN, DST, DST2, ROWOFF, GAIN) { const int n_items = ((KK) / 64) * ((NN) / 32); const float* gain_ = (GAIN); for (; it < n_items; it += NGW) transpose_item<MODE>((Wsrc), (KK), (NN), (DST), (DST2), (ROWOFF), gain_, scr, it, lane); it -= n_items; }
            if (!odd) {
                TR_JOB(0, INP(8) + (size_t)eo * D * AB_IN, D, AB_IN, W_mixa, W_mixa, 0, INP(3) + (size_t)layer * D);
                TR_JOB(0, INP(13) + (size_t)eo * D * D, D, D, W_mixb, W_mixb, 0, nullptr);
            } else {
                TR_JOB(0, INP(14) + (size_t)eo * D * C_IN, D, C_IN, W_mixa, W_mixa, 0, INP(3) + (size_t)layer * D);
                TR_JOB(0, INP(17) + (size_t)eo * 512 * 3072, 512, 3072, (bf16*)(W + W_UQ), (bf16*)(W + W_UQ), 0, nullptr);
                TR_JOB(1, INP(18) + (size_t)eo * 256 * 4096, 256, 4096, (bf16*)(W + W_UK), (bf16*)(W + W_UV), 0, nullptr);
                TR_JOB(0, INP(19) + (size_t)eo * D * D, D, D, W_mixb, W_mixb, 0, nullptr);
            }
            TR_JOB(0, INP(21) + (size_t)layer * D * D, D, D, W_wkv, W_wkv, 0, nullptr);
            TR_JOB(0, INP(22) + (size_t)layer * D * D, D, D, W_wkv, W_wkv, D, nullptr);
            TR_JOB(0, INP(23) + (size_t)layer * D * D, D, D, (bf16*)(W + W_WO), (bf16*)(W + W_WO), 0, nullptr);
            TR_JOB(0, INP(24) + (size_t)layer * D * DFF, D, DFF, (bf16*)(W + W_W1), (bf16*)(W + W_W1), 0, INP(6) + (size_t)layer * D);
            TR_JOB(0, INP(25) + (size_t)layer * DFF * D, DFF, D, (bf16*)(W + W_W2), (bf16*)(W + W_W2), 0, nullptr);
#undef TR_JOB
            {
                const float* wq = INP(20) + (size_t)layer * D * D; v4u* dst = (v4u*)(W + W_WQ); const float* gq = INP(4) + (size_t)layer * D;
                for (int i = gtid; i < D * D / 8; i += GT) { const f32x4 a = ((const f32x4*)wq)[2 * i], b = ((const f32x4*)wq)[2 * i + 1]; const float gk = gq[i >> 8];
                    v4u o; o.x = pk2(a.x * gk, a.y * gk); o.y = pk2(a.z * gk, a.w * gk); o.z = pk2(b.x * gk, b.y * gk); o.w = pk2(b.z * gk, b.w * gk); dst[i] = o; }
            }
            if (!odd) {
                const float* wsp = INP(10) + (size_t)eo * 8 * 128 * 128; bf16* WSM = (bf16*)(ws + WS_WSM);
                for (int i = gtid; i < 8 * 128 * 128; i += GT) { const int ii = (i >> 7) & 127, jj = i & 127; const float v = ((jj >> 6) <= (ii >> 6)) ? wsp[i] : 0.f; WSM[i] = (bf16)(pk2(v, 0.f) & 0xffffu); }
            }
            if (layer == 0) {
                const int* positions = (const int*)INP(2); float* ROPE = (float*)(ws + WS_ROPE); const LAS float* fv = (const LAS float*)(lds + INVF_OFF);
                for (int i = gtid; i < M * 32; i += GT) { const int row = i >> 5, fi = i & 31;
                    const float ang = (float)positions[row] * fv[fi];
                    const double rev = (double)ang * 0.15915494309189535; const float fr = (float)(rev - floor(rev));
                    ROPE[(size_t)row * 64 + fi] = __builtin_amdgcn_cosf(fr); ROPE[(size_t)row * 64 + 32 + fi] = __builtin_amdgcn_sinf(fr); }
            }
            norm_rows_bf16(INP(1), INP(5) + (size_t)layer * D, (bf16*)(ws + WS_MEMN), MMEM, gw, NGW, lane);
            if (layer == 0) {
                const float* xin = INP(0);
                for (int m = gw; m < M; m += NGW) {
                    const f32x4* xr = (const f32x4*)(xin + (size_t)m * D) + lane; v2u* o8 = (v2u*)(XB + (size_t)m * D) + lane; float sq = 0.f;
#pragma unroll
                    for (int j = 0; j < 8; ++j) { const f32x4 v = xr[64 * j]; v2u w; w.x = pk2(v.x, v.y); w.y = pk2(v.z, v.w); o8[64 * j] = w;
                        sq += (bflo(w.x) * bflo(w.x) + bfhi(w.x) * bfhi(w.x)) + (bflo(w.y) * bflo(w.y) + bfhi(w.y) * bfhi(w.y)); }
                    sq = wave_sum(sq); if (lane < 32) SS[2 * SSP_SLOT + (size_t)m * 32 + lane] = (lane == 0) ? sq : 0.f;
                }
            }
            __syncthreads();
        }
        }
        SEAM(pb + 0);

        if (((PHM >> 1) & 1) && IN(pb + 1)) {
            _Pragma("nounroll") for (int rep_ = 0; rep_ < ((((DBL) >> 1) & 1) ? 2 : 1); ++rep_) {
            {
                PHASE_PTRS();
                pg8::Gemm g{XB, (const bf16*)(W + W_MIXA), D, D, D, M / 256, odd ? C_INP / 256 : AB_IN / 256, 1, 1, 0, 0, 0, 0};
                pg8::Order S; S.init(g, G, cid);
                pg8::Epi<pg8::EP_BF16> E{(void*)BIG, SS + 2 * SSP_SLOT, odd ? C_INP : AB_IN, 256, 0, 0, 0, 0, 1.f, (DBLK) ? rep_ : 0};
                pg8::gemm_phase<pg8::Epi<pg8::EP_BF16>, true>(lds + RING_OFF, g, S, E, 0, lds + XLDS_OFF);
            }
            {
                PHASE_PTRS();
                pg8::Gemm g{(const bf16*)(ws + WS_MEMN), (const bf16*)(W + W_WKV), D, D, D, MMEM / 256, 2 * D / 256, 1, 1, 0, 0, 0, 0};
                pg8::Order S; S.init(g, G, cid);
                pg8::Epi<pg8::EP_BF16> E{(void*)(ws + WS_KVM), nullptr, 2 * D, 256, 0, 0, 0, 0, 1.f, (DBLK) ? rep_ : 0};
                pg8::gemm_phase<pg8::Epi<pg8::EP_BF16>, true>(lds + RING_OFF, g, S, E, 0, lds + XLDS_OFF);
            }
        }
        }
        SEAM(pb + 1);

        if (((PHM >> 2) & 1) && IN(pb + 2)) {
            _Pragma("nounroll") for (int rep_ = 0; rep_ < ((((DBL) >> 2) & 1) ? 2 : 1); ++rep_) {
            if (!odd) {
                PHASE_PTRS();
                const bf16* Z = (const bf16*)BIG; const bf16* WSM = (const bf16*)(ws + WS_WSM);
                const float* vng = INP(9) + (size_t)eo * 1024; const float* bsp = INP(11) + (size_t)eo * 1024; const float* cw = INP(12) + (size_t)eo * 3 * 1024;
                for (int uidx = cid; uidx < 2048; uidx += G) {
                    const int nb = uidx >> 3, gq = uidx & 7; const size_t row0 = (size_t)nb * 128;
                    {
                        const int j = tid >> 2, qd = tid & 3;
                        const v4u* vp = (const v4u*)(Z + (row0 + j) * AB_IN + 1024 + gq * 128 + qd * 32);
                        float vals[32]; float ss = 0.f;
#pragma unroll
                        for (int k4 = 0; k4 < 4; ++k4) { const v4u w = vp[k4]; const unsigned ww[4] = {w.x, w.y, w.z, w.w};
#pragma unroll
                            for (int e = 0; e < 4; ++e) { const float a = gelu_tanh(bflo(ww[e])), b = gelu_tanh(bfhi(ww[e])); vals[k4 * 8 + 2 * e] = a; vals[k4 * 8 + 2 * e + 1] = b; ss += a * a + b * b; } }
                        ss += __shfl_xor(ss, 1); ss += __shfl_xor(ss, 2);
                        const float rinv = 1.0f / sqrtf(ss * (1.0f / 128.0f) + RMS_EPS);
                        const float* gp = vng + gq * 128 + qd * 32;
                        LAS bf16* vt = (LAS bf16*)(lds + RING_OFF);
#pragma unroll
                        for (int k = 0; k < 32; ++k) vt[(qd * 32 + k) * 136 + j] = (bf16)(pk2(vals[k] * rinv * gp[k], 0.f) & 0xffffu);
                    }
                    __syncthreads();
                    {
                        const int r = lane & 15, g4 = lane >> 4; const int irow = 16 * wave + r;
                        bf16x8 wf[4];
#pragma unroll
                        for (int s = 0; s < 4; ++s) wf[s] = *(const bf16x8*)(WSM + ((size_t)(gq * 128 + irow) * 128 + 32 * s + 8 * g4));
                        const float bs = bsp[gq * 128 + irow];
                        const bf16* up = Z + (row0 + irow) * AB_IN + gq * 128 + 4 * g4;
                        bf16* yp = XN + (row0 + irow) * D + gq * 128 + 4 * g4;
#pragma unroll
                        for (int t = 0; t < 8; ++t) {
                            f32x4 acc = (f32x4){0.f, 0.f, 0.f, 0.f};
#pragma unroll
                            for (int s = 0; s < 4; ++s) { const bf16x8 vf = *(const LAS bf16x8*)(lds + RING_OFF + (16 * t + r) * 272 + (32 * s + 8 * g4) * 2);
                                acc = __builtin_amdgcn_mfma_f32_16x16x32_bf16(vf, wf[s], acc, 0, 0, 0); }
                            const v2u uw = *(const v2u*)(up + 16 * t);
                            const float u0 = gelu_tanh(bflo(uw.x)), u1 = gelu_tanh(bfhi(uw.x)), u2 = gelu_tanh(bflo(uw.y)), u3 = gelu_tanh(bfhi(uw.y));
                            v2u o; o.x = pk2(u0 * (acc.x + bs), u1 * (acc.y + bs)); o.y = pk2(u2 * (acc.z + bs), u3 * (acc.w + bs));
                            *(v2u*)(yp + 16 * t) = o;
                        }
                    }
                    __syncthreads();
                }
                for (int i = gtid; i < M * 128; i += GT) {
                    const int row = i >> 7, c8 = (i & 127) * 8, tpos = row & (SEQ - 1);
                    const bf16* zr = Z + (size_t)row * AB_IN;
                    const v4u bg = *(const v4u*)(zr + 2048 + c8);
                    float zc[3][8];
#pragma unroll
                    for (int k = 0; k < 3; ++k) {
                        if (tpos - k >= 0) { const v4u cg = *(const v4u*)(zr - (size_t)k * AB_IN + 3072 + c8), hh = *(const v4u*)(zr - (size_t)k * AB_IN + 4096 + c8);
                            const unsigned cgw[4] = {cg.x, cg.y, cg.z, cg.w}, hw[4] = {hh.x, hh.y, hh.z, hh.w};
#pragma unroll
                            for (int e = 0; e < 4; ++e) { zc[k][2 * e] = bflo(cgw[e]) * bflo(hw[e]); zc[k][2 * e + 1] = bfhi(cgw[e]) * bfhi(hw[e]); } }
                        else {
#pragma unroll
                            for (int e = 0; e < 8; ++e) zc[k][e] = 0.f; }
                    }
                    const unsigned bgw[4] = {bg.x, bg.y, bg.z, bg.w}; float y[8];
#pragma unroll
                    for (int e = 0; e < 8; ++e) { const float bgv = (e & 1) ? bfhi(bgw[e >> 1]) : bflo(bgw[e >> 1]);
                        const float conv = cw[c8 + e] * zc[2][e] + cw[1024 + c8 + e] * zc[1][e] + cw[2048 + c8 + e] * zc[0][e]; y[e] = bgv * conv; }
                    v4u o; o.x = pk2(y[0], y[1]); o.y = pk2(y[2], y[3]); o.z = pk2(y[4], y[5]); o.w = pk2(y[6], y[7]);
                    *(v4u*)(XN + (size_t)row * D + 1024 + c8) = o;
                }
            } else {
                PHASE_PTRS();
                const bf16* LAT = (const bf16*)BIG; bf16* CQN = (bf16*)(BIG + B_CQN); bf16* CKVN = (bf16*)(BIG + B_CKVN); bf16* KR = (bf16*)(BIG + B_KR);
                const float* ROPE = (const float*)(ws + WS_ROPE);
                const float* gqn = INP(15) + (size_t)eo * 512; const float* gkv = INP(16) + (size_t)eo * 256;
                for (int m = gw; m < M; m += NGW) {
                    const bf16* lp = LAT + (size_t)m * C_INP;
                    {
                        const v4u w = *(const v4u*)(lp + 8 * lane); const unsigned ww[4] = {w.x, w.y, w.z, w.w}; float f[8]; float ss = 0.f;
#pragma unroll
                        for (int e = 0; e < 4; ++e) { f[2 * e] = bflo(ww[e]); f[2 * e + 1] = bfhi(ww[e]); ss += f[2 * e] * f[2 * e] + f[2 * e + 1] * f[2 * e + 1]; }
                        const float rr = 1.0f / sqrtf(wave_sum(ss) * (1.0f / 512.0f) + RMS_EPS); const float* gp = gqn + 8 * lane;
                        v4u o; o.x = pk2(f[0] * rr * gp[0], f[1] * rr * gp[1]); o.y = pk2(f[2] * rr * gp[2], f[3] * rr * gp[3]); o.z = pk2(f[4] * rr * gp[4], f[5] * rr * gp[5]); o.w = pk2(f[6] * rr * gp[6], f[7] * rr * gp[7]);
                        *(v4u*)(CQN + (size_t)m * 512 + 8 * lane) = o;
                    }
                    {
                        const int l2 = lane & 31; const v4u w = *(const v4u*)(lp + 512 + 8 * l2); const unsigned ww[4] = {w.x, w.y, w.z, w.w}; float f[8]; float ss = 0.f;
#pragma unroll
                        for (int e = 0; e < 4; ++e) { f[2 * e] = bflo(ww[e]); f[2 * e + 1] = bfhi(ww[e]); ss += f[2 * e] * f[2 * e] + f[2 * e + 1] * f[2 * e + 1]; }
                        if (lane >= 32) ss = 0.f;
                        const float rr = 1.0f / sqrtf(wave_sum(ss) * (1.0f / 256.0f) + RMS_EPS); const float* gp = gkv + 8 * l2;
                        v4u o; o.x = pk2(f[0] * rr * gp[0], f[1] * rr * gp[1]); o.y = pk2(f[2] * rr * gp[2], f[3] * rr * gp[3]); o.z = pk2(f[4] * rr * gp[4], f[5] * rr * gp[5]); o.w = pk2(f[6] * rr * gp[6], f[7] * rr * gp[7]);
                        if (lane < 32) *(v4u*)(CKVN + (size_t)m * 256 + 8 * l2) = o;
                    }
                    if (lane < 4) {
                        const v4u w1 = *(const v4u*)(lp + 768 + 8 * lane), w2 = *(const v4u*)(lp + 800 + 8 * lane);
                        const unsigned a1[4] = {w1.x, w1.y, w1.z, w1.w}, a2[4] = {w2.x, w2.y, w2.z, w2.w};
                        const float* rp = ROPE + (size_t)m * 64 + 8 * lane; float o1[8], o2[8];
#pragma unroll
                        for (int e = 0; e < 8; ++e) { const float xa = (e & 1) ? bfhi(a1[e >> 1]) : bflo(a1[e >> 1]), xb = (e & 1) ? bfhi(a2[e >> 1]) : bflo(a2[e >> 1]);
                            const float cc = rp[e], sn = rp[32 + e]; o1[e] = xa * cc - xb * sn; o2[e] = xb * cc + xa * sn; }
                        v4u q1, q2; q1.x = pk2(o1[0], o1[1]); q1.y = pk2(o1[2], o1[3]); q1.z = pk2(o1[4], o1[5]); q1.w = pk2(o1[6], o1[7]);
                        q2.x = pk2(o2[0], o2[1]); q2.y = pk2(o2[2], o2[3]); q2.z = pk2(o2[4], o2[5]); q2.w = pk2(o2[6], o2[7]);
                        *(v4u*)(KR + (size_t)m * 64 + 8 * lane) = q1; *(v4u*)(KR + (size_t)m * 64 + 32 + 8 * lane) = q2;
                    }
                }
            }
            __syncthreads();
            {
                PHASE_PTRS();
                pg8::Gemm g{(const bf16*)(ws + WS_KVM), (const bf16*)(W + W_WQ), 2 * D, D, 512, MMEM / 256, D / 256, 4, 1, 512, 0, 512, 0};
                pg8::Order S; S.init(g, G, cid);
                pg8::Epi<pg8::EP_BF16> E{(void*)(ws + WS_WQKT), nullptr, D, 1024, 256, 0, 0, 0, 1.f, (DBLK) ? rep_ : 0};
                pg8::gemm_phase<pg8::Epi<pg8::EP_BF16>, true>(lds + RING_OFF, g, S, E, 0, lds + XLDS_OFF);
            }
            {
                PHASE_PTRS();
                pg8::Gemm g{(const bf16*)(W + W_WO), (const bf16*)(ws + WS_KVM) + D, D, 2 * D, 512, D / 256, 1, 4, BATCH, 512, 0, 512, (long)256 * 2 * D};
                pg8::Order S; S.init(g, G, cid);
                pg8::Epi<pg8::EP_BF16> E{(void*)(ws + WS_VWOT), nullptr, 1024, 256, 0, 2048, 256, 0, 1.f, (DBLK) ? rep_ : 0};
                pg8::gemm_phase<pg8::Epi<pg8::EP_BF16>, true>(lds + RING_OFF, g, S, E, 0, lds + XLDS_OFF);
            }
        }
        }
        SEAM(pb + 2);

        if (((PHM >> 3) & 1) && odd && IN(pb + 3)) {
            _Pragma("nounroll") for (int rep_ = 0; rep_ < ((((DBL) >> 3) & 1) ? 2 : 1); ++rep_) {
            {
                PHASE_PTRS();
                pg8::Gemm g{(const bf16*)(BIG + B_CQN), (const bf16*)(W + W_UQ), 512, 512, 512, M / 256, 3072 / 256, 1, 1, 0, 0, 0, 0};
                pg8::Order S; S.init(g, G, cid);
                pg8::Epi<pg8::EP_BF16> E{(void*)(BIG + B_Q), nullptr, 3072, 256, 0, 0, 0, 0, 1.f, (DBLK) ? rep_ : 0};
                pg8::gemm_phase<pg8::Epi<pg8::EP_BF16>, true>(lds + RING_OFF, g, S, E, 0, lds + XLDS_OFF);
            }
            {
                PHASE_PTRS();
                pg8::Gemm g{(const bf16*)(BIG + B_CKVN), (const bf16*)(W + W_UK), 256, 256, 256, M / 256, 2048 / 256, 1, 1, 0, 0, 0, 0};
                pg8::Order S; S.init(g, G, cid);
                pg8::Epi<pg8::EP_BF16> E{(void*)(BIG + B_KN), nullptr, 2048, 256, 0, 0, 0, 0, 1.f, (DBLK) ? rep_ : 0};
                pg8::gemm_phase<pg8::Epi<pg8::EP_BF16>, true>(lds + RING_OFF, g, S, E, 0, lds + XLDS_OFF);
            }
            {
                PHASE_PTRS();
                pg8::Gemm g{(const bf16*)(W + W_UV), (const bf16*)(BIG + B_CKVN), 256, 256, 256, 2048 / 256, SEQ / 256, 1, BATCH, 0, 0, 0, (long)SEQ * 256};
                pg8::Order S; S.init(g, G, cid);
                pg8::Epi<pg8::EP_BF16> E{(void*)(BIG + B_VT), nullptr, 2048, 256, 0, 2048, 0, 0, 1.f, (DBLK) ? rep_ : 0};
                pg8::gemm_phase<pg8::Epi<pg8::EP_BF16>, true>(lds + RING_OFF, g, S, E, 0, lds + XLDS_OFF);
            }
        }
        }
        if (odd) SEAM(pb + 3);

        if (((PHM >> 5) & 1) && odd && IN(pb + 5)) {
            _Pragma("nounroll") for (int rep_ = 0; rep_ < ((((DBL) >> 5) & 1) ? 2 : 1); ++rep_) {
            PHASE_PTRS();
            const att::T t{(const bf16*)(BIG + B_Q), (const bf16*)(BIG + B_KN), (const bf16*)(BIG + B_KR), (const bf16*)(BIG + B_VT), XN, (const float*)(ws + WS_ROPE)};
            for (int idx = cid; idx < 1024; idx += G) {
                const int bh = idx >> 2, p = idx & 3, b = bh >> 4, h = bh & 15;
                att::unit(lds + RING_OFF, t, b, h, p, tid, wave, lane);
                att::unit(lds + RING_OFF, t, b, h, 7 - p, tid, wave, lane);
            }
        }
        }
        if (odd) SEAM(pb + 5);

        if (((PHM >> 6) & 1) && IN(pb + 6)) {
            _Pragma("nounroll") for (int rep_ = 0; rep_ < ((((DBL) >> 6) & 1) ? 2 : 1); ++rep_) {
            PHASE_PTRS();
            pg8::Gemm g{XN, (const bf16*)(W + W_MIXB), D, D, D, M / 256, D / 256, 1, 1, 0, 0, 0, 0};
            pg8::Order S; S.init(g, G, cid);
            pg8::Epi<pg8::EP_RESID> E{(void*)XB, SS + 0 * SSP_SLOT, D, 256, 0, 0, 0, 0, rep_ ? 0.f : 1.f, (DBLK) ? rep_ : 0};
            pg8::gemm_phase<pg8::Epi<pg8::EP_RESID>, true>(lds + RING_OFF, g, S, E, 0, lds + XLDS_OFF);
        }
        }
        SEAM(pb + 6);

        if (((PHM >> 8) & 1) && IN(pb + 8)) {
            _Pragma("nounroll") for (int rep_ = 0; rep_ < ((((DBL) >> 8) & 1) ? 2 : 1); ++rep_) {
            PHASE_PTRS();
            pg8::Gemm g{XB, (const bf16*)(ws + WS_WQKT), D, D, D, SEQ / 256, 1024 / 256, 1, BATCH, 0, (long)SEQ * D, 0, (long)1024 * D};
            pg8::Order S; S.init(g, G, cid);
            pg8::Epi<pg8::EP_SOFTMAX> E{(void*)(BIG + B_P), SS + 0 * SSP_SLOT, 1024, 256, 0, SEQ, 0, 0, 0.04419417382415922f, (DBLK) ? rep_ : 0};
            pg8::gemm_phase<pg8::Epi<pg8::EP_SOFTMAX>, true>(lds + RING_OFF, g, S, E, 0, lds + XLDS_OFF);
        }
        }
        SEAM(pb + 8);

        if (((PHM >> 10) & 1) && IN(pb + 10)) {
            _Pragma("nounroll") for (int rep_ = 0; rep_ < ((((DBL) >> 10) & 1) ? 2 : 1); ++rep_) {
            PHASE_PTRS();
            pg8::Gemm g{(const bf16*)(BIG + B_P), (const bf16*)(ws + WS_VWOT), 1024, 1024, 1024, SEQ / 256, D / 256, 1, BATCH, 0, (long)SEQ * 1024, 0, (long)D * 1024};
            pg8::Order S; S.init(g, G, cid);
            pg8::Epi<pg8::EP_RESID> E{(void*)XB, SS + 1 * SSP_SLOT, D, 256, 0, SEQ, 0, 0, rep_ ? 0.f : 1.f, (DBLK) ? rep_ : 0};
            pg8::gemm_phase<pg8::Epi<pg8::EP_RESID>, true>(lds + RING_OFF, g, S, E, 0, lds + XLDS_OFF);
        }
        }
        SEAM(pb + 10);

        if (((PHM >> 12) & 1) && IN(pb + 12)) {
            _Pragma("nounroll") for (int rep_ = 0; rep_ < ((((DBL) >> 12) & 1) ? 2 : 1); ++rep_) {
            PHASE_PTRS();
            pg8::Gemm g{XB, (const bf16*)(W + W_W1), D, D, D, M / 256, DFF / 256, 1, 1, 0, 0, 0, 0};
            pg8::Order S; S.init(g, G, cid);
            pg8::Epi<pg8::EP_RELU2> E{(void*)BIG, SS + 1 * SSP_SLOT, DFF, 256, 0, 0, 0, 0, 1.f, (DBLK) ? rep_ : 0};
            pg8::gemm_phase<pg8::Epi<pg8::EP_RELU2>, true>(lds + RING_OFF, g, S, E, ((cid >> 3) & 3) * STAG_FFN1, lds + XLDS_OFF);
        }
        }
        SEAM(pb + 12);

        if (((PHM >> 13) & 1) && IN(pb + 13)) {
            _Pragma("nounroll") for (int rep_ = 0; rep_ < ((((DBL) >> 13) & 1) ? 2 : 1); ++rep_) {
            PHASE_PTRS();
            pg8::Gemm g{(const bf16*)BIG, (const bf16*)(W + W_W2), DFF, DFF, DFF, M / 256, D / 256, 1, 1, 0, 0, 0, 0};
            pg8::Order S; S.init(g, G, cid);
            pg8::Epi<pg8::EP_RESID> E{(void*)XB, SS + 2 * SSP_SLOT, D, 256, 0, 0, 0, 0, rep_ ? 0.f : 1.f, (DBLK) ? rep_ : 0};
            pg8::gemm_phase<pg8::Epi<pg8::EP_RESID>, true>(lds + RING_OFF, g, S, E, 0, lds + XLDS_OFF);
        }
        }
        if (IN(pb + 13) && IN(pb + PH_PER_LAYER)) GRID_BAR();
    }

    if (((PHM >> 16) & 1) && IN(PH_FINAL)) {
        PHASE_PTRS();
        const float* gain = INP(7); float* OUT = (float*)ldptr(lds, 26); const float* ssl = SS + 2 * SSP_SLOT;
        for (int m = gw; m < M; m += NGW) {
            const float r = __builtin_amdgcn_rsqf(wave_sum(lane < 32 ? ssl[(size_t)m * 32 + lane] : 0.f) * (1.0f / D) + RMS_EPS);
            const v4u* xr = (const v4u*)(XB + (size_t)m * D) + lane; f32x4* orow = (f32x4*)(OUT + (size_t)m * D);
#pragma unroll
            for (int j = 0; j < 4; ++j) { const v4u w = xr[64 * j]; const int c = 8 * (lane + 64 * j);
                const f32x4 g0 = *(const f32x4*)(gain + c), g1 = *(const f32x4*)(gain + c + 4);
                orow[(c >> 2)] = (f32x4){bflo(w.x) * r * g0.x, bfhi(w.x) * r * g0.y, bflo(w.y) * r * g0.z, bfhi(w.y) * r * g0.w};
                orow[(c >> 2) + 1] = (f32x4){bflo(w.z) * r * g1.x, bfhi(w.z) * r * g1.y, bflo(w.w) * r * g1.z, bfhi(w.w) * r * g1.w}; }
        }
    }
#undef IN
#undef BOTH
#undef SEAM
}

extern "C" void kernel_launch(void* const* d_in, const int* in_sizes, int n_in, void* d_out, int out_size, void* d_ws, size_t ws_size, hipStream_t stream) {
    static int grid = 0;
    if (grid == 0) {
        if (n_in != 26 || out_size != M * D || ws_size < WS_END) { fprintf(stderr, "kernel_launch: unexpected problem (n_in %d, out %d, ws %zu)\n", n_in, out_size, ws_size); grid = -1; return; }
        int dev = 0, cus = 0, per_cu = 0;
        if (hipGetDevice(&dev) != hipSuccess || hipDeviceGetAttribute(&cus, hipDeviceAttributeMultiprocessorCount, dev) != hipSuccess) { grid = -1; return; }
        if (hipFuncSetAttribute((const void*)trunk_fwd, hipFuncAttributeMaxDynamicSharedMemorySize, LDS_BYTES) != hipSuccess) { fprintf(stderr, "kernel_launch: hipFuncSetAttribute failed\n"); grid = -1; return; }
        if (hipOccupancyMaxActiveBlocksPerMultiprocessor(&per_cu, (const void*)trunk_fwd, NWAVES * 64, LDS_BYTES) != hipSuccess || per_cu < 1) { fprintf(stderr, "kernel_launch: occupancy query says %d\n", per_cu); }
        (void)hipGetLastError();
        grid = cus;
    }
    if (grid < 0) return;
    if (hipMemsetAsync((char*)d_ws + WS_CTL, 0, CTL_ZERO_BYTES, stream) != hipSuccess) return;
    Args a{};
    for (int i = 0; i < 26; ++i) a.in[i] = (const float*)d_in[i];
    a.out = (float*)d_out; a.ws = (unsigned char*)d_ws;
    for (int i = 0; i < 32; ++i) a.inv_freq[i] = (float)pow(10000.0, -(double)(2 * i) / 64.0);
#if MK_PER_PHASE
    for (int p = 0; p < PH_TOTAL; ++p) {
        const int k = p % PH_PER_LAYER, layer = p / PH_PER_LAYER;
        if (p < PH_FINAL) { if (k == 4 || k == 7 || k == 9 || k == 11 || k > 13) continue; if (!(layer & 1) && (k == 3 || k == 5)) continue; }
        a.ph_lo = p; a.ph_hi = p + 1;
        hipLaunchKernelGGL(trunk_fwd, dim3(grid), dim3(NWAVES * 64), LDS_BYTES, stream, a);
    }
#else
    a.ph_lo = 0; a.ph_hi = PH_TOTAL;
    hipLaunchKernelGGL(trunk_fwd, dim3(grid), dim3(NWAVES * 64), LDS_BYTES, stream, a);
#endif
}
```

```cpp
#include <hip/hip_runtime.h>
#include <cstdio>
#include <cstdint>
#include <cmath>

#ifndef PHM
#define PHM 0xFFFFF
#endif
#ifndef DBL
#define DBL 0
#endif
#ifndef DBLK
#define DBLK 0
#endif
#ifndef STAG_FFN1
#define STAG_FFN1 0
#endif
#ifndef DBLC
#define DBLC 0
#endif
#ifndef NT_STORE
#define NT_STORE 0
#endif
#ifndef MK_PER_PHASE
#define MK_PER_PHASE 0
#endif

namespace pg8 {
#define PG8_LAS __attribute__((address_space(3)))
typedef unsigned short bf16_t;
typedef short bf16x8 __attribute__((ext_vector_type(8)));
typedef float f32x4 __attribute__((ext_vector_type(4)));
typedef unsigned u32x4 __attribute__((ext_vector_type(4)));
constexpr int BM = 256, BK = 64, HALF = 128, HTB = HALF * BK * 2, STAGE_BYTES = 8 * HTB, NXCD = 8, WGM = 8;

__host__ __device__ __forceinline__ int lds_byte(int r, int c) { const int st = (r >> 4) * 2 + (c >> 5), rr = r & 15, cc = c & 31, ob = rr * 64 + cc * 2; return st * 1024 + (ob ^ (((ob >> 9) & 1) << 5)); }
__host__ __device__ __forceinline__ void stage_rc(int b, int& R, int& C) { const int st = b / 1024, sb = b % 1024, swz = sb ^ (((sb >> 9) & 1) << 5); R = (st >> 1) * 16 + swz / 64; C = (st & 1) * 32 + (swz % 64) / 2; }
__host__ __device__ __forceinline__ int perm32(int rho) { const int n = rho >> 4, i = rho & 15; return 8 * (i >> 2) + 4 * n + (i & 3); }

struct Unit { int pm, pn, z0, z1; };
struct Gemm { const bf16_t* A; const bf16_t* Bt; int lda, ldb, K, nM, nN, nZ0, nZ1; long aZ0, aZ1, bZ0, bZ1; };

struct Order {
    int nN, nwg, G, c, lgM, lgZ0, mN;
    __device__ __forceinline__ void init(const Gemm& g, int G_, int c_) { nN = g.nN; nwg = g.nM * g.nZ0 * g.nZ1 * g.nN; G = G_; c = c_;
        lgM = 31 - __builtin_clz(g.nM); lgZ0 = 31 - __builtin_clz(g.nZ0); mN = ((1 << 20) + g.nN - 1) / g.nN; }
    __device__ __forceinline__ bool next(int i, Unit& u) const {
        const int L = i * G + c; if (L >= nwg) return false;
        const int wgid = (L & 7) * (nwg >> 3) + (L >> 3);
        const int w8 = wgid >> 3, gid = (int)(((unsigned)w8 * (unsigned)mN) >> 20);
        const int gm = gid * 8 + (wgid & 7); u.pn = w8 - gid * nN;
        u.pm = gm & ((1 << lgM) - 1); const int z = gm >> lgM; u.z0 = z & ((1 << lgZ0) - 1); u.z1 = z >> lgZ0; return true;
    }
};

__device__ __forceinline__ unsigned cvt_pk_bf16(float lo, float hi) { unsigned r; asm volatile("v_cvt_pk_bf16_f32 %0, %1, %2" : "=v"(r) : "v"(lo), "v"(hi)); return r; }

enum { EP_BF16 = 0, EP_RELU2 = 1, EP_RESID = 2, EP_F32S = 3, EP_SOFTMAX = 4 };
__device__ __forceinline__ float bf_lo(unsigned w) { return __uint_as_float(w << 16); }
__device__ __forceinline__ float bf_hi(unsigned w) { return __uint_as_float(w & 0xffff0000u); }
__device__ __forceinline__ float xsum16(float v) { const auto r = __builtin_amdgcn_permlane16_swap(__float_as_uint(v), __float_as_uint(v), false, false); return __uint_as_float(r[0]) + __uint_as_float(r[1]); }
__device__ __forceinline__ float xsum32(float v) { const auto r = __builtin_amdgcn_permlane32_swap(__float_as_uint(v), __float_as_uint(v), false, false); return __uint_as_float(r[0]) + __uint_as_float(r[1]); }
__device__ __forceinline__ float xmax16(float v) { const auto r = __builtin_amdgcn_permlane16_swap(__float_as_uint(v), __float_as_uint(v), false, false); return fmaxf(__uint_as_float(r[0]), __uint_as_float(r[1])); }
__device__ __forceinline__ float xmax32(float v) { const auto r = __builtin_amdgcn_permlane32_swap(__float_as_uint(v), __float_as_uint(v), false, false); return fmaxf(__uint_as_float(r[0]), __uint_as_float(r[1])); }
template <int MODE> struct Epi {
    static constexpr bool PERM = (MODE != EP_F32S);
    void* out; float* ss; int ldc, rM, rZ0, rZ1, cZ0, cZ1; float scale; int skip;
    __device__ __forceinline__ void operator()(f32x4 (&acc)[2][2][4][2], const Unit& u, int wr, int wc, int fr, int fq, int tid, int& rs_key, PG8_LAS unsigned char* xlds) const {
        if (skip) { asm volatile("" :: "v"(acc[0][0][0][0]), "v"(acc[1][1][3][1])); return; }
        const int row0 = u.pm * rM + u.z0 * rZ0 + u.z1 * rZ1 + wr * 64 + fr;
        const int colb = u.pn * BM + u.z0 * cZ0 + u.z1 * cZ1 + wc * 32;
        if constexpr (MODE == EP_RESID) {
            bf16_t* O = (bf16_t*)out; const int col0 = colb + 8 * fq;
            u32x4 cur[2], nxt[2];
#pragma unroll
            for (int bj = 0; bj < 2; ++bj) cur[bj] = *(const u32x4*)(O + (size_t)row0 * ldc + col0 + bj * HALF);
#pragma unroll
            for (int gi = 0; gi < 8; ++gi) { const int ai = gi >> 2, m = gi & 3; const int rowg = row0 + ai * HALF + m * 16; bf16_t* rowp = O + (size_t)rowg * ldc + col0;
                if (gi < 7) { const int a2 = (gi + 1) >> 2, m2 = (gi + 1) & 3; const bf16_t* rp2 = O + (size_t)(row0 + a2 * HALF + m2 * 16) * ldc + col0;
#pragma unroll
                    for (int bj = 0; bj < 2; ++bj) nxt[bj] = *(const u32x4*)(rp2 + bj * HALF); }
                asm volatile("" ::: "memory");
                float sq = 0.f;
#pragma unroll
                for (int bj = 0; bj < 2; ++bj) { const f32x4 v0 = acc[ai][bj][m][0], v1 = acc[ai][bj][m][1]; const u32x4 x = cur[bj];
                    u32x4 w; w.x = cvt_pk_bf16(bf_lo(x.x) + v0[0] * scale, bf_hi(x.x) + v0[1] * scale); w.y = cvt_pk_bf16(bf_lo(x.y) + v0[2] * scale, bf_hi(x.y) + v0[3] * scale);
                    w.z = cvt_pk_bf16(bf_lo(x.z) + v1[0] * scale, bf_hi(x.z) + v1[1] * scale); w.w = cvt_pk_bf16(bf_lo(x.w) + v1[2] * scale, bf_hi(x.w) + v1[3] * scale);
                    *(u32x4*)(rowp + bj * HALF) = w;
                    sq += (bf_lo(w.x) * bf_lo(w.x) + bf_hi(w.x) * bf_hi(w.x)) + (bf_lo(w.y) * bf_lo(w.y) + bf_hi(w.y) * bf_hi(w.y));
                    sq += (bf_lo(w.z) * bf_lo(w.z) + bf_hi(w.z) * bf_hi(w.z)) + (bf_lo(w.w) * bf_lo(w.w) + bf_hi(w.w) * bf_hi(w.w)); }
                sq = xsum16(sq); sq = xsum32(sq);
                if (fq == 0) ss[(size_t)rowg * 32 + u.pn * 4 + wc] = sq;
                asm volatile("" ::: "memory");
#pragma unroll
                for (int bj = 0; bj < 2; ++bj) cur[bj] = nxt[bj]; }
        } else {
            float rs[2][4];
            if (ss) {
                PG8_LAS float* rtab = (PG8_LAS float*)xlds;
                const int key = u.pm * rM + u.z0 * rZ0 + u.z1 * rZ1;
                if (key != rs_key) { rs_key = key;
                    const float* pp = ss + (size_t)(key + (tid >> 1)) * 32 + 16 * (tid & 1);
                    const f32x4 a = *(const f32x4*)pp, b = *(const f32x4*)(pp + 4), c = *(const f32x4*)(pp + 8), d = *(const f32x4*)(pp + 12);
                    float sv = (((a[0] + a[1]) + (a[2] + a[3])) + ((b[0] + b[1]) + (b[2] + b[3]))) + (((c[0] + c[1]) + (c[2] + c[3])) + ((d[0] + d[1]) + (d[2] + d[3])));
                    sv += __shfl_xor(sv, 1);
                    if ((tid & 1) == 0) rtab[tid >> 1] = __builtin_amdgcn_rsqf(sv * (1.0f / 2048.0f) + 1e-6f);
                    asm volatile("s_waitcnt lgkmcnt(0)" ::: "memory"); __builtin_amdgcn_s_barrier(); asm volatile("" ::: "memory");
                }
#pragma unroll
                for (int ai = 0; ai < 2; ++ai)
#pragma unroll
                    for (int m = 0; m < 4; ++m) rs[ai][m] = rtab[ai * HALF + wr * 64 + m * 16 + fr];
            } else {
#pragma unroll
                for (int ai = 0; ai < 2; ++ai)
#pragma unroll
                    for (int m = 0; m < 4; ++m) rs[ai][m] = 1.0f;
            }
            if constexpr (MODE == EP_SOFTMAX) {
                PG8_LAS float* smax = (PG8_LAS float*)(xlds + 1024); PG8_LAS float* ssum = (PG8_LAS float*)(xlds + 5120);
                const float c2 = scale * 1.4426950408889634f; const int trow = wr * 64 + fr;
#pragma unroll
                for (int ai = 0; ai < 2; ++ai)
#pragma unroll
                    for (int m = 0; m < 4; ++m) { const float sc = rs[ai][m] * c2; float mx = -3.0e38f;
#pragma unroll
                        for (int bj = 0; bj < 2; ++bj)
#pragma unroll
                            for (int n = 0; n < 2; ++n) { f32x4 v = acc[ai][bj][m][n] * sc; acc[ai][bj][m][n] = v; mx = fmaxf(fmaxf(mx, fmaxf(v[0], v[1])), fmaxf(v[2], v[3])); }
                        mx = xmax16(mx); mx = xmax32(mx);
                        if (fq == 0) smax[(ai * HALF + m * 16 + trow) * 4 + wc] = mx; }
                asm volatile("s_waitcnt lgkmcnt(0)" ::: "memory"); __builtin_amdgcn_s_barrier(); asm volatile("" ::: "memory");
#pragma unroll
                for (int ai = 0; ai < 2; ++ai)
#pragma unroll
                    for (int m = 0; m < 4; ++m) { const f32x4 m4 = *(const PG8_LAS f32x4*)(smax + (ai * HALF + m * 16 + trow) * 4); const float mx = fmaxf(fmaxf(m4[0], m4[1]), fmaxf(m4[2], m4[3])); float sm = 0.f;
#pragma unroll
                        for (int bj = 0; bj < 2; ++bj)
#pragma unroll
                            for (int n = 0; n < 2; ++n) { f32x4 v = acc[ai][bj][m][n];
#pragma unroll
                                for (int j = 0; j < 4; ++j) { v[j] = __builtin_amdgcn_exp2f(v[j] - mx); sm += v[j]; }
                                acc[ai][bj][m][n] = v; }
                        sm = xsum16(sm); sm = xsum32(sm);
                        if (fq == 0) ssum[(ai * HALF + m * 16 + trow) * 4 + wc] = sm; }
                asm volatile("s_waitcnt lgkmcnt(0)" ::: "memory"); __builtin_amdgcn_s_barrier(); asm volatile("" ::: "memory");
                bf16_t* O = (bf16_t*)out; const int col0 = colb + 8 * fq;
#pragma unroll
                for (int ai = 0; ai < 2; ++ai)
#pragma unroll
                    for (int m = 0; m < 4; ++m) { const f32x4 s4 = *(const PG8_LAS f32x4*)(ssum + (ai * HALF + m * 16 + trow) * 4); const float inv = 1.0f / ((s4[0] + s4[1]) + (s4[2] + s4[3]));
                        bf16_t* rowp = O + (size_t)(row0 + ai * HALF + m * 16) * ldc + col0;
#pragma unroll
                        for (int bj = 0; bj < 2; ++bj) { const f32x4 v0 = acc[ai][bj][m][0] * inv, v1 = acc[ai][bj][m][1] * inv;
                            u32x4 w; w.x = cvt_pk_bf16(v0[0], v0[1]); w.y = cvt_pk_bf16(v0[2], v0[3]); w.z = cvt_pk_bf16(v1[0], v1[1]); w.w = cvt_pk_bf16(v1[2], v1[3]);
                            *(u32x4*)(rowp + bj * HALF) = w; } }
            } else if constexpr (PERM) {
                bf16_t* O = (bf16_t*)out; const int col0 = colb + 8 * fq;
#pragma unroll
                for (int ai = 0; ai < 2; ++ai)
#pragma unroll
                    for (int m = 0; m < 4; ++m) { bf16_t* rowp = O + (size_t)(row0 + ai * HALF + m * 16) * ldc + col0;
#pragma unroll
                        for (int bj = 0; bj < 2; ++bj) { f32x4 v0 = acc[ai][bj][m][0] * rs[ai][m], v1 = acc[ai][bj][m][1] * rs[ai][m];
                            if constexpr (MODE == EP_RELU2) {
#pragma unroll
                                for (int j = 0; j < 4; ++j) { const float a = fmaxf(v0[j], 0.f), b = fmaxf(v1[j], 0.f); v0[j] = a * a; v1[j] = b * b; } }
                            u32x4 w; w.x = cvt_pk_bf16(v0[0], v0[1]); w.y = cvt_pk_bf16(v0[2], v0[3]); w.z = cvt_pk_bf16(v1[0], v1[1]); w.w = cvt_pk_bf16(v1[2], v1[3]);
                            if (NT_STORE) __builtin_nontemporal_store(w, (u32x4*)(rowp + bj * HALF)); else *(u32x4*)(rowp + bj * HALF) = w; } }
            } else {
                float* C = (float*)out; const int col0 = colb + 4 * fq;
#pragma unroll
                for (int ai = 0; ai < 2; ++ai)
#pragma unroll
                    for (int m = 0; m < 4; ++m) { const size_t off = (size_t)(row0 + ai * HALF + m * 16) * ldc + col0; const float sc = rs[ai][m] * scale;
#pragma unroll
                        for (int bj = 0; bj < 2; ++bj)
#pragma unroll
                            for (int n = 0; n < 2; ++n) *(f32x4*)(C + off + bj * HALF + n * 16) = acc[ai][bj][m][n] * sc; }
            }
        }
    }
};

template <class EpiT, bool ALIGN_EPI>
__device__ __forceinline__ void gemm_phase(PG8_LAS unsigned char* lds, const Gemm g, const Order& S, const EpiT& E, int stagger_ticks = 0, PG8_LAS unsigned char* xlds = nullptr  ) {
    if (stagger_ticks > 0) {
        const unsigned long long t0 = __builtin_amdgcn_s_memrealtime();
        while (__builtin_amdgcn_s_memrealtime() - t0 < (unsigned long long)stagger_ticks) __builtin_amdgcn_s_sleep(8);
    }
    int tid = threadIdx.x; asm volatile("" : "+v"(tid));
    const int wid = __builtin_amdgcn_readfirstlane(tid >> 6), lane = tid & 63, wr = wid >> 2, wc = wid & 3, fr = lane & 15, fq = lane >> 4;
    const int K = g.K, nt = K / BK;
    const int tmul_ = (DBLC && E.skip) ? 0 : 1;
    unsigned voffA[2], voffB[2];
#pragma unroll
    for (int i = 0; i < 2; ++i) { int R, C; stage_rc(tid * 16 + i * 8192, R, C); const int Rb = EpiT::PERM ? ((R & ~31) + perm32(R & 31)) : R;
        voffA[i] = (unsigned)(R * g.lda + C) * 2u; voffB[i] = (unsigned)(Rb * g.ldb + C) * 2u; }
    const size_t kstep = (size_t)(BK * 2);
    const size_t hstepA = (size_t)HALF * g.lda * 2, hstepB = (size_t)HALF * g.ldb * 2;
    const unsigned ldsw = (unsigned)wid * 1024u;
    const int aoff = lds_byte(wr * 64 + fr, fq * 8), boff = lds_byte(wc * 32 + fr, fq * 8);
#define PG8_SA(b, h) (((b) * 2 + (h)) * HTB)
#define PG8_SB(b, h) ((4 + (b) * 2 + (h)) * HTB)
#define PG8_STAGE(bufoff, gbase, voff) do { _Pragma("unroll") for (int _i = 0; _i < 2; ++_i) \
        __builtin_amdgcn_global_load_lds((const unsigned*)((const char*)(gbase) + (voff)[_i]), (PG8_LAS unsigned*)(lds + (bufoff) + ldsw + _i * 8192), 16, 0, 0); } while (0)
#define PG8_LDA(dst, b, h) do { _Pragma("unroll") for (int m = 0; m < 4; ++m) _Pragma("unroll") for (int k = 0; k < 2; ++k) dst[m][k] = *(const PG8_LAS bf16x8*)(lds + PG8_SA(b, h) + aoff + m * 2048 + k * 1024); } while (0)
#define PG8_LDB(dst, b, h) do { _Pragma("unroll") for (int n = 0; n < 2; ++n) _Pragma("unroll") for (int k = 0; k < 2; ++k) dst[n][k] = *(const PG8_LAS bf16x8*)(lds + PG8_SB(b, h) + boff + n * 2048 + k * 1024); } while (0)
#define PG8_MMA(ai, bj, At, Bt) do { __builtin_amdgcn_s_setprio(1); _Pragma("unroll") for (int m = 0; m < 4; ++m) _Pragma("unroll") for (int n = 0; n < 2; ++n) _Pragma("unroll") for (int k = 0; k < 2; ++k) \
        acc[ai][bj][m][n] = __builtin_amdgcn_mfma_f32_16x16x32_bf16(Bt[n][k], At[m][k], acc[ai][bj][m][n], 0, 0, 0); __builtin_amdgcn_s_setprio(0); } while (0)
#define PG8_WAIT_V(n) asm volatile("s_waitcnt vmcnt(" #n ")" ::: "memory")
#define PG8_WAIT_L(n) asm volatile("s_waitcnt lgkmcnt(" #n ")" ::: "memory")
#define PG8_BAR __builtin_amdgcn_s_barrier()
#define PG8_SCHED __builtin_amdgcn_sched_barrier(0)
#define PG8_TILEA(u) ((const char*)(g.A + (u).z0 * g.aZ0 + (u).z1 * g.aZ1 + (long)((u).pm * tmul_) * BM * g.lda))
#define PG8_TILEB(u) ((const char*)(g.Bt + (u).z0 * g.bZ0 + (u).z1 * g.bZ1 + (long)((u).pn * tmul_) * BM * g.ldb))
    Unit cur, nxt; int ui = 0;
    if (!S.next(0, cur)) return;
    f32x4 acc[2][2][4][2];
#pragma unroll
    for (int a = 0; a < 2; ++a)
#pragma unroll
        for (int b = 0; b < 2; ++b)
#pragma unroll
            for (int m = 0; m < 4; ++m)
#pragma unroll
                for (int n = 0; n < 2; ++n) acc[a][b][m][n] = (f32x4){0.f, 0.f, 0.f, 0.f};
    bf16x8 At[4][2], B0[2][2], B1[2][2];
    int rs_key = -0x7fffffff;
    const char* cA = PG8_TILEA(cur); const char* cB = PG8_TILEB(cur);
    PG8_STAGE(PG8_SB(0, 0), cB, voffB); PG8_STAGE(PG8_SB(0, 1), cB + hstepB, voffB); PG8_STAGE(PG8_SA(0, 0), cA, voffA); PG8_STAGE(PG8_SA(0, 1), cA + hstepA, voffA);
    if (wr == 1) PG8_BAR;
    PG8_WAIT_V(2); PG8_BAR;
    PG8_STAGE(PG8_SB(1, 0), cB + kstep, voffB); PG8_STAGE(PG8_SA(1, 0), cA + kstep, voffA); PG8_STAGE(PG8_SB(1, 1), cB + hstepB + kstep, voffB);
    PG8_WAIT_V(6); PG8_BAR;
    for (;;) {
        const bool has_next = S.next(ui + 1, nxt);
        const char* nA = has_next ? PG8_TILEA(nxt) : cA; const char* nB = has_next ? PG8_TILEB(nxt) : cB;
        for (int t = 0; t < nt; t += 2) {
            const bool last = (t == nt - 2);
            const char* a1 = cA + (size_t)(t + 1) * kstep;
            const char* a2 = last ? nA : cA + (size_t)(t + 2) * kstep; const char* b2 = last ? nB : cB + (size_t)(t + 2) * kstep;
            const char* a3 = a2 + kstep; const char* b3 = b2 + kstep;
            PG8_LDB(B0, 0, 0); PG8_LDB(B1, 0, 1); PG8_SCHED; PG8_LDA(At, 0, 0); PG8_STAGE(PG8_SA(1, 1), a1 + hstepA, voffA);
            PG8_WAIT_V(8); PG8_WAIT_L(0); PG8_BAR; PG8_MMA(0, 0, At, B0); PG8_MMA(0, 1, At, B1); PG8_BAR; PG8_SCHED;
            PG8_LDA(At, 0, 1); PG8_STAGE(PG8_SB(0, 0), b2, voffB); PG8_STAGE(PG8_SB(0, 1), b2 + hstepB, voffB); PG8_STAGE(PG8_SA(0, 0), a2, voffA);
            PG8_WAIT_V(8); PG8_WAIT_L(0); PG8_BAR; PG8_MMA(1, 0, At, B0); PG8_MMA(1, 1, At, B1); PG8_BAR; PG8_SCHED;
            PG8_LDB(B0, 1, 0); PG8_LDB(B1, 1, 1); PG8_SCHED; PG8_LDA(At, 1, 0); PG8_STAGE(PG8_SA(0, 1), a2 + hstepA, voffA);
            PG8_WAIT_V(8); PG8_WAIT_L(0); PG8_BAR; PG8_MMA(0, 0, At, B0); PG8_MMA(0, 1, At, B1); PG8_BAR; PG8_SCHED;
            PG8_LDA(At, 1, 1); PG8_STAGE(PG8_SB(1, 0), b3, voffB); PG8_STAGE(PG8_SB(1, 1), b3 + hstepB, voffB); PG8_STAGE(PG8_SA(1, 0), a3, voffA);
            PG8_WAIT_V(8); PG8_WAIT_L(0); PG8_BAR; PG8_MMA(1, 0, At, B0); PG8_MMA(1, 1, At, B1); PG8_BAR; PG8_SCHED;
        }
        if constexpr (ALIGN_EPI) { if (wr == 0) PG8_BAR; }
        E(acc, cur, wr, wc, fr, fq, tid, rs_key, xlds);
        if (!has_next) break;
#pragma unroll
        for (int a = 0; a < 2; ++a)
#pragma unroll
            for (int b = 0; b < 2; ++b)
#pragma unroll
                for (int m = 0; m < 4; ++m)
#pragma unroll
                    for (int n = 0; n < 2; ++n) acc[a][b][m][n] = (f32x4){0.f, 0.f, 0.f, 0.f};
        cur = nxt; cA = nA; cB = nB; ++ui;
        if constexpr (ALIGN_EPI) { if (wr == 1) PG8_BAR; }
    }
    PG8_WAIT_V(0);
    if constexpr (!ALIGN_EPI) { if (wr == 0) PG8_BAR; }
    PG8_BAR;
#undef PG8_SA
#undef PG8_SB
#undef PG8_STAGE
#undef PG8_LDA
#undef PG8_LDB
#undef PG8_MMA
#undef PG8_WAIT_V
#undef PG8_WAIT_L
#undef PG8_BAR
#undef PG8_SCHED
#undef PG8_TILEA
#undef PG8_TILEB
}
}

constexpr int NWAVES = 8;
constexpr int BATCH = 16, SEQ = 2048, D = 2048, M = BATCH * SEQ, NMEM = 256, MMEM = BATCH * NMEM, DEPTH = 4;
constexpr int AB_IN = 5120, C_IN = 832, C_INP = 1024, DFF = 8192;
constexpr float RMS_EPS = 1e-6f;

constexpr size_t MiB = 1u << 20;
constexpr size_t WS_CTL = 0, CTL_ZERO_BYTES = 1 * MiB;

constexpr size_t WS_ROPE = 8 * MiB;
constexpr size_t WS_W = 16 * MiB;
constexpr size_t W_MIXA = 0, W_UQ = 4 * MiB, W_UK = 8 * MiB, W_UV = 9 * MiB, W_MIXB = 20 * MiB, W_WQ = 28 * MiB, W_WKV = 36 * MiB, W_WO = 52 * MiB, W_W1 = 60 * MiB, W_W2 = 92 * MiB;
constexpr size_t WS_XN = 144 * MiB;
constexpr size_t WS_BIG = 272 * MiB;
constexpr size_t B_Q = 0, B_KN = 192 * MiB, B_VT = 320 * MiB, B_CQN = 448 * MiB, B_CKVN = 480 * MiB, B_KR = 496 * MiB;
constexpr size_t B_S = 0, B_P = 128 * MiB;
constexpr size_t WS_WQKT = 784 * MiB, WS_VWOT = 848 * MiB, WS_KVM = 912 * MiB, WS_MEMN = 944 * MiB, WS_WSM = 960 * MiB, WS_XB = 961 * MiB, WS_SSP = 1089 * MiB, WS_END = 1101 * MiB;
constexpr size_t SSP_SLOT = (size_t)M * 32;
constexpr int CW_TMO = 0, CW_BAR = 4096;

constexpr int RING_OFF = 0, RING_BYTES = 131072;
constexpr int LDSCTL_OFF = RING_BYTES, MISC_OFF = LDSCTL_OFF + 320;
constexpr int LDS_BYTES = 147456;
constexpr int PTAB_OFF = LDSCTL_OFF + 512;
constexpr int XLDS_OFF = LDSCTL_OFF + 2048;
constexpr int INVF_OFF = LDSCTL_OFF + 1024;

#define LAS __attribute__((address_space(3)))
typedef unsigned short bf16;
typedef unsigned v4u __attribute__((ext_vector_type(4)));
typedef unsigned v2u __attribute__((ext_vector_type(2)));
typedef float f32x4 __attribute__((ext_vector_type(4)));
typedef short bf16x8 __attribute__((ext_vector_type(8)));
typedef short s16x4 __attribute__((ext_vector_type(4)));
#define LDS_WAIT() asm volatile("s_waitcnt lgkmcnt(0)" ::: "memory")

__device__ __forceinline__ float bf2f(unsigned short b) { return __uint_as_float(((unsigned)b) << 16); }
__device__ __forceinline__ float bflo(unsigned w) { return __uint_as_float(w << 16); }
__device__ __forceinline__ float bfhi(unsigned w) { return __uint_as_float(w & 0xffff0000u); }
__device__ __forceinline__ unsigned pk2(float lo, float hi) { return pg8::cvt_pk_bf16(lo, hi); }
__device__ __forceinline__ float gelu_tanh(float x) {
    const float y = 0.7978845608028654f * (x + 0.044715f * x * x * x);
    return x / (1.0f + __expf(-2.0f * y));
}

#define XB_TMO      128
#define XB_XCNT(j)  (256  + 64 * (j))
#define XB_XSUB(j)  (1280 + 64 * (j))
#define XB_XGEN(j)  (2304 + 64 * (j))
#define XB_TOP      3328
#define XB_TOPGEN   3392
#define XCD_BAR_WORDS 3456
#define XB_SPIN_CAP (1u << 18)
__device__ __forceinline__ unsigned xb_ld(unsigned* p)              { return __hip_atomic_load(p, __ATOMIC_RELAXED, __HIP_MEMORY_SCOPE_AGENT); }
__device__ __forceinline__ unsigned xb_add(unsigned* p, unsigned v) { return __hip_atomic_fetch_add(p, v, __ATOMIC_RELAXED, __HIP_MEMORY_SCOPE_AGENT); }
__device__ __forceinline__ unsigned xb_xcc_id() { return (unsigned)__builtin_amdgcn_s_getreg((3 << 11) | 20) & 0xFu; }
#define XB_SPIN(cond, bar) do { unsigned _sp = 0; while (cond) { __builtin_amdgcn_s_sleep(1); \
    if ((++_sp & 255u) == 0u) { if (xb_ld(&(bar)[XB_TMO])) break; if (_sp > XB_SPIN_CAP) { atomicAdd(&(bar)[XB_TMO], 1u); break; } } } } while (0)
struct XcdBarrier { unsigned* bar; unsigned x; volatile LAS unsigned* st; };
__device__ __forceinline__ XcdBarrier xcd_barrier_post(unsigned* bar, volatile LAS unsigned* st) {
    XcdBarrier b; b.bar = bar; b.x = xb_xcc_id(); b.st = st;
    if (threadIdx.x == 0) (void)xb_add(&bar[XB_XCNT(b.x)], 1u);
    return b;
}
__device__ __forceinline__ void xcd_barrier_complete(unsigned* bar, unsigned x, unsigned& nloc, unsigned& nx) {
    const unsigned G = gridDim.x * gridDim.y * gridDim.z;
    unsigned sum, cnt, mine, sp = 0u;
    for (;;) {
        sum = 0u; cnt = 0u; mine = 0u;
#pragma unroll
        for (unsigned j = 0; j < 16; ++j) { const unsigned c = xb_ld(&bar[XB_XCNT(j)]); sum += c; cnt += (c > 0u) ? 1u : 0u; mine = (j == x) ? c : mine; }
        if (sum == G) break;
        __builtin_amdgcn_s_sleep(1);
        if ((++sp & 255u) == 0u) { if (xb_ld(&bar[XB_TMO])) break; if (sp > XB_SPIN_CAP) { atomicAdd(&bar[XB_TMO], 1u); break; } }
    }
    nloc = mine > 0u ? mine : 1u; nx = cnt > 0u ? cnt : 1u;
}
__device__ __forceinline__ void xcd_barrier(const XcdBarrier& b) {
    asm volatile("s_waitcnt vmcnt(0)" ::: "memory");
    __syncthreads();
    if (threadIdx.x == 0) {
        unsigned* bar = b.bar;
        __builtin_amdgcn_s_waitcnt(0);
        unsigned nloc = b.st[0], nx = b.st[1];
        if (nloc == 0u) { xcd_barrier_complete(bar, b.x, nloc, nx); b.st[0] = nloc; b.st[1] = nx; }
        const unsigned old = xb_add(&bar[XB_XSUB(b.x)], 1u);
        const unsigned gen = old / nloc;
        if (old + 1u == (gen + 1u) * nloc) {
            __builtin_amdgcn_fence(__ATOMIC_RELEASE, "agent");
            asm volatile("s_waitcnt vmcnt(0)" ::: "memory");
            const unsigned og = xb_add(&bar[XB_TOP], 1u);
            const unsigned tg = og / nx;
            if (og + 1u == (tg + 1u) * nx) xb_add(&bar[XB_TOPGEN], 1u);
            else XB_SPIN(xb_ld(&bar[XB_TOPGEN]) == tg, bar);
            __builtin_amdgcn_fence(__ATOMIC_ACQUIRE, "agent");
            xb_add(&bar[XB_XGEN(b.x)], 1u);
            asm volatile("s_waitcnt vmcnt(0)" ::: "memory");
        } else {
            XB_SPIN(xb_ld(&bar[XB_XGEN(b.x)]) == gen, bar);
            __builtin_amdgcn_fence(__ATOMIC_ACQUIRE, "agent");
            asm volatile("s_waitcnt vmcnt(0)" ::: "memory");
        }
    }
    __syncthreads();
}

__device__ __forceinline__ float wave_sum(float v) {
#pragma unroll
    for (int o = 1; o < 64; o <<= 1) v += __shfl_xor(v, o);
    return v;
}
__device__ __forceinline__ float wave_max(float v) {
#pragma unroll
    for (int o = 1; o < 64; o <<= 1) v = fmaxf(v, __shfl_xor(v, o));
    return v;
}

__device__ __forceinline__ unsigned char* ldptr(LAS unsigned char* lds, int k) {
    const volatile LAS unsigned* p = (const volatile LAS unsigned*)(lds + PTAB_OFF) + 2 * k;
    const unsigned lo = __builtin_amdgcn_readfirstlane(p[0]), hi = __builtin_amdgcn_readfirstlane(p[1]);
    return (unsigned char*)(__attribute__((address_space(1))) unsigned char*)(((unsigned long long)hi << 32) | (unsigned long long)lo);
}
template <int MODE>
__device__ __forceinline__ void transpose_item(const float* W, int K, int N, bf16* WT, bf16* WT2, int row_off, const float* gain  , LAS float* scr, int item, int lane) {
    const int nblk = N / 32, kb = item / nblk, nb = item % nblk, k0 = 64 * kb, n0 = 32 * nb;
    {
        const int kq = lane >> 3, nq = lane & 7; f32x4 v[8]; float gk[8];
#pragma unroll
        for (int i = 0; i < 8; ++i) v[i] = *(const f32x4*)(W + (size_t)(k0 + 8 * i + kq) * N + n0 + 4 * nq);
#pragma unroll
        for (int i = 0; i < 8; ++i) gk[i] = gain ? gain[k0 + 8 * i + kq] : 1.0f;
#pragma unroll
        for (int i = 0; i < 8; ++i) { LAS float* d = scr + (8 * i + kq) * 33 + 4 * nq; d[0] = v[i].x * gk[i]; d[1] = v[i].y * gk[i]; d[2] = v[i].z * gk[i]; d[3] = v[i].w * gk[i]; }
    }
    LDS_WAIT(); asm volatile("" ::: "memory");
    bf16* dst = WT; int r0 = row_off + n0;
    if (MODE == 1) { const int h = n0 >> 8, w = n0 & 255; if (w < 128) { dst = WT; r0 = h * 128 + w; } else { dst = WT2; r0 = h * 128 + w - 128; } }
    const int c = lane & 7;
#pragma unroll
    for (int j = 0; j < 4; ++j) { const int n = (lane >> 3) + 8 * j; const LAS float* s = scr + (8 * c) * 33 + n;
        v4u o; o.x = pk2(s[0 * 33], s[1 * 33]); o.y = pk2(s[2 * 33], s[3 * 33]); o.z = pk2(s[4 * 33], s[5 * 33]); o.w = pk2(s[6 * 33], s[7 * 33]);
        *(v4u*)(dst + (size_t)(r0 + n) * K + k0 + 8 * c) = o; }
    LDS_WAIT(); asm volatile("" ::: "memory");
}

__device__ __forceinline__ void norm_rows_bf16(const float* X, const float* gain, bf16* out, int nrows, int gw, int NGW, int lane) {
    for (int m = gw; m < nrows; m += NGW) {
        const f32x4* xr = (const f32x4*)(X + (size_t)m * D) + lane;
        f32x4 v[8]; float s = 0.f;
#pragma unroll
        for (int j = 0; j < 8; ++j) { v[j] = xr[64 * j]; s += (v[j].x * v[j].x + v[j].y * v[j].y) + (v[j].z * v[j].z + v[j].w * v[j].w); }
        const float r = 1.0f / sqrtf(wave_sum(s) * (1.0f / D) + RMS_EPS);
        v2u* o8 = (v2u*)(out + (size_t)m * D) + lane;
#pragma unroll
        for (int j = 0; j < 8; ++j) { const f32x4 gv = ((const f32x4*)gain)[lane + 64 * j]; v2u w; w.x = pk2(v[j].x * r * gv.x, v[j].y * r * gv.y); w.y = pk2(v[j].z * r * gv.z, v[j].w * r * gv.w); o8[64 * j] = w; }
    }
}

namespace att {
constexpr int KT_BYTES = 64 * 384, VROW = 144, VT_BYTES = 128 * VROW, BUF = KT_BYTES + VT_BYTES;
struct T { const bf16* Q; const bf16* KN; const bf16* KR; const bf16* VT; bf16* O; const float* rope; };
constexpr float QK_SCALE = 0.07216878364870322f;
constexpr float C2 = QK_SCALE * 1.4426950408889634f;

__device__ __forceinline__ void unit(LAS unsigned char* lds, const T& t, int b, int h, int u, int tid, int wave, int lane) {
    const int r = lane & 15, g = lane >> 4;
    const int q0 = 256 * u + 32 * wave, cq = q0 >> 6, ntiles = 4 * u + 4;
    const size_t rowb = (size_t)b * SEQ;
    bf16x8 qf[2][6];
#pragma unroll
    for (int qs = 0; qs < 2; ++qs) {
        const bf16* qp = t.Q + (rowb + q0 + 16 * qs + r) * 3072 + h * 192 + 8 * g;
#pragma unroll
        for (int s = 0; s < 6; ++s) qf[qs][s] = *(const bf16x8*)(qp + 32 * s);
        const float* rp = t.rope + (rowb + q0 + 16 * qs + r) * 64 + 8 * g;
        const f32x4 c0 = *(const f32x4*)rp, c1 = *(const f32x4*)(rp + 4), s0 = *(const f32x4*)(rp + 32), s1 = *(const f32x4*)(rp + 36);
        const float cs[8] = {c0.x, c0.y, c0.z, c0.w, c1.x, c1.y, c1.z, c1.w}, sn[8] = {s0.x, s0.y, s0.z, s0.w, s1.x, s1.y, s1.z, s1.w};
        bf16x8 x1 = qf[qs][4], x2 = qf[qs][5]; float o1[8], o2[8];
#pragma unroll
        for (int e = 0; e < 8; ++e) { const float a = bf2f((unsigned short)x1[e]), bb = bf2f((unsigned short)x2[e]); o1[e] = a * cs[e] - bb * sn[e]; o2[e] = bb * cs[e] + a * sn[e]; }
        v4u w1, w2; w1.x = pk2(o1[0], o1[1]); w1.y = pk2(o1[2], o1[3]); w1.z = pk2(o1[4], o1[5]); w1.w = pk2(o1[6], o1[7]);
        w2.x = pk2(o2[0], o2[1]); w2.y = pk2(o2[2], o2[3]); w2.z = pk2(o2[4], o2[5]); w2.w = pk2(o2[6], o2[7]);
        qf[qs][4] = __builtin_bit_cast(bf16x8, w1); qf[qs][5] = __builtin_bit_cast(bf16x8, w2);
    }
    constexpr int VB0 = 2 * KT_BYTES;
    v4u kreg[3], vreg[2];
#define ATT_LOAD(jt) do { int t2 = tid; asm volatile("" : "+v"(t2)); \
        _Pragma("unroll") for (int i = 0; i < 3; ++i) { const int ch = t2 + 512 * i, key = ch / 24, c16 = ch % 24; const size_t krow = rowb + (size_t)(jt) * 64 + key; \
            const bf16* sp = (c16 < 16) ? t.KN + krow * 2048 + h * 128 + c16 * 8 : t.KR + krow * 64 + (c16 - 16) * 8; kreg[i] = *(const v4u*)sp; } \
        _Pragma("unroll") for (int i = 0; i < 2; ++i) { const int ch = t2 + 512 * i, dv = ch >> 3, c16 = ch & 7; \
            vreg[i] = *(const v4u*)(t.VT + ((size_t)b * 2048 + h * 128 + dv) * 2048 + (jt) * 64 + c16 * 8); } } while (0)
#define ATT_STORE(kbo_, vbo_) do { int t2 = tid; asm volatile("" : "+v"(t2)); \
        _Pragma("unroll") for (int i = 0; i < 3; ++i) { const int ch = t2 + 512 * i, key = ch / 24, c16 = ch % 24; *(LAS v4u*)(lds + (kbo_) + key * 384 + ((c16 ^ (key & 7)) << 4)) = kreg[i]; } \
        _Pragma("unroll") for (int i = 0; i < 2; ++i) { const int ch = t2 + 512 * i, dv = ch >> 3, c16 = ch & 7; *(LAS v4u*)(lds + (vbo_) + dv * VROW + c16 * 16) = vreg[i]; } } while (0)
    float mrow[2] = {-1e30f, -1e30f}, lsum[2] = {0.f, 0.f};
    f32x4 oacc[8][2];
#pragma unroll
    for (int tt = 0; tt < 8; ++tt) { oacc[tt][0] = (f32x4){0.f, 0.f, 0.f, 0.f}; oacc[tt][1] = (f32x4){0.f, 0.f, 0.f, 0.f}; }
    const int offE = (g ^ (r & 7)) << 4, offO = offE ^ 64;
    const int kbase = r * 384, vbase = r * VROW + 8 * g;
    bf16x8 pf[2][2];
    pf[0][0] = pf[0][1] = pf[1][0] = pf[1][1] = (bf16x8){0, 0, 0, 0, 0, 0, 0, 0};
#define ATT_PV(vbo_) do { _Pragma("unroll") for (int s2 = 0; s2 < 2; ++s2) _Pragma("unroll") for (int tt = 0; tt < 8; ++tt) { \
        const v2u lo = *(const LAS v2u*)(lds + (vbo_) + vbase + tt * (16 * VROW) + s2 * 64); \
        const v2u hi = *(const LAS v2u*)(lds + (vbo_) + vbase + tt * (16 * VROW) + s2 * 64 + 32); \
        const v4u vv = {lo.x, lo.y, hi.x, hi.y}; const bf16x8 vf = __builtin_bit_cast(bf16x8, vv); \
        oacc[tt][0] = __builtin_amdgcn_mfma_f32_16x16x32_bf16(vf, pf[0][s2], oacc[tt][0], 0, 0, 0); \
        oacc[tt][1] = __builtin_amdgcn_mfma_f32_16x16x32_bf16(vf, pf[1][s2], oacc[tt][1], 0, 0, 0); } } while (0)
    const bool rot = wave >= 4;

    ATT_LOAD(0); ATT_STORE(0, VB0);
    __syncthreads();
    int vprev = 2, vcur = 0, vnext = 1;
    for (int jt = 0; jt < ntiles; ++jt) {
        const int kbo = (jt & 1) * KT_BYTES, kbn = ((jt + 1) & 1) * KT_BYTES;
        const bool more = (jt + 1 < ntiles);
        if (more) ATT_LOAD(jt + 1);
        if (rot && jt >= 1 && jt - 1 <= cq) ATT_PV(VB0 + vprev * VT_BYTES);
        if (jt <= cq) {
            f32x4 sc[4][2];
#pragma unroll
            for (int kt = 0; kt < 4; ++kt) { sc[kt][0] = (f32x4){0.f, 0.f, 0.f, 0.f}; sc[kt][1] = (f32x4){0.f, 0.f, 0.f, 0.f}; }
#pragma unroll
            for (int s = 0; s < 6; ++s)
#pragma unroll
                for (int kt = 0; kt < 4; ++kt) {
                    const bf16x8 kf = *(const LAS bf16x8*)(lds + kbo + kbase + kt * (16 * 384) + (s >> 1) * 128 + ((s & 1) ? offO : offE));
                    sc[kt][0] = __builtin_amdgcn_mfma_f32_16x16x32_bf16(kf, qf[0][s], sc[kt][0], 0, 0, 0);
                    sc[kt][1] = __builtin_amdgcn_mfma_f32_16x16x32_bf16(kf, qf[1][s], sc[kt][1], 0, 0, 0);
                }
#pragma unroll
            for (int qs = 0; qs < 2; ++qs) {
                float mx = sc[0][qs][0];
#pragma unroll
                for (int kt = 0; kt < 4; ++kt)
#pragma unroll
                    for (int j = 0; j < 4; ++j) mx = fmaxf(mx, sc[kt][qs][j]);
                mx = pg8::xmax16(mx); mx = pg8::xmax32(mx);
                const float mnew = fmaxf(mrow[qs], mx), alpha = __builtin_amdgcn_exp2f((mrow[qs] - mnew) * C2), mc = mnew * C2;
                mrow[qs] = mnew;
                float ps = 0.f; float p[4][4];
#pragma unroll
                for (int kt = 0; kt < 4; ++kt)
#pragma unroll
                    for (int j = 0; j < 4; ++j) { p[kt][j] = __builtin_amdgcn_exp2f(sc[kt][qs][j] * C2 - mc); ps += p[kt][j]; }
                lsum[qs] = lsum[qs] * alpha + ps;
#pragma unroll
                for (int s2 = 0; s2 < 2; ++s2) { v4u w; w.x = pk2(p[2 * s2][0], p[2 * s2][1]); w.y = pk2(p[2 * s2][2], p[2 * s2][3]); w.z = pk2(p[2 * s2 + 1][0], p[2 * s2 + 1][1]); w.w = pk2(p[2 * s2 + 1][2], p[2 * s2 + 1][3]);
                    pf[qs][s2] = __builtin_bit_cast(bf16x8, w); }
#pragma unroll
                for (int tt = 0; tt < 8; ++tt) oacc[tt][qs] = oacc[tt][qs] * alpha;
            }
            if (!rot) ATT_PV(VB0 + vcur * VT_BYTES);
        }
        if (more) ATT_STORE(kbn, VB0 + vnext * VT_BYTES);
        __syncthreads();
        vprev = vcur; vcur = vnext; vnext = (vnext == 2) ? 0 : vnext + 1;
    }
    if (rot && ntiles - 1 <= cq) ATT_PV(VB0 + vprev * VT_BYTES);
    __syncthreads();
#undef ATT_LOAD
#undef ATT_STORE
#undef ATT_PV
#pragma unroll
    for (int qs = 0; qs < 2; ++qs) {
        float l = lsum[qs]; l = pg8::xsum16(l); l = pg8::xsum32(l);
        const float inv = 1.0f / l;
        bf16* op = t.O + (rowb + q0 + 16 * qs + r) * 2048 + h * 128 + 4 * g;
#pragma unroll
        for (int tt = 0; tt < 8; ++tt) { const f32x4 o = oacc[tt][qs] * inv; v2u w; w.x = pk2(o.x, o.y); w.y = pk2(o.z, o.w); *(v2u*)(op + 16 * tt) = w; }
    }
}
}

struct Args {
    const float* in[26]; float* out; unsigned char* ws; int ph_lo, ph_hi; float inv_freq[32];
};
constexpr int PH_PER_LAYER = 16, PH_FINAL = DEPTH * PH_PER_LAYER, PH_TOTAL = PH_FINAL + 1;

__global__ void __launch_bounds__(NWAVES * 64, 2) trunk_fwd(Args args) {
    extern __shared__ __attribute__((aligned(16))) unsigned char lds_raw[];
    LAS unsigned char* lds = (LAS unsigned char*)lds_raw;
    volatile LAS unsigned* MISC = (volatile LAS unsigned*)(lds + MISC_OFF);
    const int wave = __builtin_amdgcn_readfirstlane((int)threadIdx.x >> 6);
    const int G = gridDim.x, cid = blockIdx.x;
    const int gw = cid * NWAVES + wave, NGW = G * NWAVES, GT = G * NWAVES * 64;
    for (int u = threadIdx.x; u < (LDS_BYTES - LDSCTL_OFF) / 4; u += NWAVES * 64) ((LAS unsigned*)(lds + LDSCTL_OFF))[u] = 0u;
    __syncthreads();
    if (threadIdx.x == 0) {
        LAS unsigned long long* pt = (LAS unsigned long long*)(lds + PTAB_OFF);
#pragma unroll
        for (int k = 0; k < 26; ++k) pt[k] = (unsigned long long)args.in[k];
        pt[26] = (unsigned long long)args.out; pt[27] = (unsigned long long)args.ws;
        LAS float* fv = (LAS float*)(lds + INVF_OFF);
#pragma unroll
        for (int k = 0; k < 32; ++k) fv[k] = args.inv_freq[k];
    }
    __syncthreads();
#if MK_PER_PHASE
#define GRID_BAR() do { } while (0)
#else
    (void)xcd_barrier_post((unsigned*)(args.ws + WS_CTL) + CW_BAR, MISC + 8);
#define GRID_BAR() do { XcdBarrier b_; b_.bar = (unsigned*)(ldptr(lds, 27) + WS_CTL) + CW_BAR; unsigned x_ = xb_xcc_id(); asm volatile("" : "+s"(x_)); b_.x = x_; b_.st = MISC + 8; xcd_barrier(b_); } while (0)
#endif
    const int lo = args.ph_lo, hi = args.ph_hi;
#define IN(k) (lo <= (k) && (k) < hi)
#define BOTH(k) (IN(k) && IN((k) + 1))
#define SEAM(k) do { if (BOTH(k)) GRID_BAR(); } while (0)
#define INP(k) ((const float*)ldptr(lds, (k)))
#define PHASE_IDS() int tid = threadIdx.x; asm volatile("" : "+v"(tid)); const int lane = tid & 63, gtid = cid * (NWAVES * 64) + tid; (void)lane; (void)gtid
#define PHASE_PTRS() PHASE_IDS(); unsigned char* ws = ldptr(lds, 27); bf16* XB = (bf16*)(ws + WS_XB); float* SS = (float*)(ws + WS_SSP); unsigned char* W = ws + WS_W; bf16* XN = (bf16*)(ws + WS_XN); unsigned char* BIG = ws + WS_BIG; (void)XB; (void)SS; (void)W; (void)XN; (void)BIG

    for (int layer = 0; layer < DEPTH; ++layer) {
        const int pb = layer * PH_PER_LAYER;
        const bool odd = (layer & 1) != 0; const int eo = layer >> 1;

        if (((PHM >> 0) & 1) && IN(pb + 0)) {
            _Pragma("nounroll") for (int rep_ = 0; rep_ < ((((DBL) >> 0) & 1) ? 2 : 1); ++rep_) {
            PHASE_PTRS();
            LAS float* scr = (LAS float*)(lds + RING_OFF + wave * 16384);
            bf16* W_mixa = (bf16*)(W + W_MIXA); bf16* W_mixb = (bf16*)(W + W_MIXB); bf16* W_wkv = (bf16*)(W + W_WKV);
            int it = gw;
#define TR_JOB(MODE, Wsrc, KK, NN, DST, DST2, ROWOFF, GAIN) { const int n_items = ((KK) / 64) * ((NN) / 32); const float* gain_ = (GAIN); for (; it < n_items; it += NGW) transpose_item<MODE>((Wsrc), (KK), (NN), (DST), (DST2), (ROWOFF), gain_, scr, it, lane); it -= n_items; }
            if (!odd) {
                TR_JOB(0, INP(8) + (size_t)eo * D * AB_IN, D, AB_IN, W_mixa, W_mixa, 0, INP(3) + (size_t)layer * D);
                TR_JOB(0, INP(13) + (size_t)eo * D * D, D, D, W_mixb, W_mixb, 0, nullptr);
            } else {
                TR_JOB(0, INP(14) + (size_t)eo * D * C_IN, D, C_IN, W_mixa, W_mixa, 0, INP(3) + (size_t)layer * D);
                TR_JOB(0, INP(17) + (size_t)eo * 512 * 3072, 512, 3072, (bf16*)(W + W_UQ), (bf16*)(W + W_UQ), 0, nullptr);
                TR_JOB(1, INP(18) + (size_t)eo * 256 * 4096, 256, 4096, (bf16*)(W + W_UK), (bf16*)(W + W_UV), 0, nullptr);
                TR_JOB(0, INP(19) + (size_t)eo * D * D, D, D, W_mixb, W_mixb, 0, nullptr);
            }
            TR_JOB(0, INP(21) + (size_t)layer * D * D, D, D, W_wkv, W_wkv, 0, nullptr);
            TR_JOB(0, INP(22) + (size_t)layer * D * D, D, D, W_wkv, W_wkv, D, nullptr);
            TR_JOB(0, INP(23) + (size_t)layer * D * D, D, D, (bf16*)(W + W_WO), (bf16*)(W + W_WO), 0, nullptr);
            TR_JOB(0, INP(24) + (size_t)layer * D * DFF, D, DFF, (bf16*)(W + W_W1), (bf16*)(W + W_W1), 0, INP(6) + (size_t)layer * D);
            TR_JOB(0, INP(25) + (size_t)layer * DFF * D, DFF, D, (bf16*)(W + W_W2), (bf16*)(W + W_W2), 0, nullptr);
#undef TR_JOB
            {
                const float* wq = INP(20) + (size_t)layer * D * D; v4u* dst = (v4u*)(W + W_WQ); const float* gq = INP(4) + (size_t)layer * D;
                for (int i = gtid; i < D * D / 8; i += GT) { const f32x4 a = ((const f32x4*)wq)[2 * i], b = ((const f32x4*)wq)[2 * i + 1]; const float gk = gq[i >> 8];
                    v4u o; o.x = pk2(a.x * gk, a.y * gk); o.y = pk2(a.z * gk, a.w * gk); o.z = pk2(b.x * gk, b.y * gk); o.w = pk2(b.z * gk, b.w * gk); dst[i] = o; }
            }
            if (!odd) {
                const float* wsp = INP(10) + (size_t)eo * 8 * 128 * 128; bf16* WSM = (bf16*)(ws + WS_WSM);
                for (int i = gtid; i < 8 * 128 * 128; i += GT) { const int ii = (i >> 7) & 127, jj = i & 127; const float v = ((jj >> 6) <= (ii >> 6)) ? wsp[i] : 0.f; WSM[i] = (bf16)(pk2(v, 0.f) & 0xffffu); }
            }
            if (layer == 0) {
                const int* positions = (const int*)INP(2); float* ROPE = (float*)(ws + WS_ROPE); const LAS float* fv = (const LAS float*)(lds + INVF_OFF);
                for (int i = gtid; i < M * 32; i += GT) { const int row = i >> 5, fi = i & 31;
                    const float ang = (float)positions[row] * fv[fi];
                    const double rev = (double)ang * 0.15915494309189535; const float fr = (float)(rev - floor(rev));
                    ROPE[(size_t)row * 64 + fi] = __builtin_amdgcn_cosf(fr); ROPE[(size_t)row * 64 + 32 + fi] = __builtin_amdgcn_sinf(fr); }
            }
            norm_rows_bf16(INP(1), INP(5) + (size_t)layer * D, (bf16*)(ws + WS_MEMN), MMEM, gw, NGW, lane);
            if (layer == 0) {
                const float* xin = INP(0);
                for (int m = gw; m < M; m += NGW) {
                    const f32x4* xr = (const f32x4*)(xin + (size_t)m * D) + lane; v2u* o8 = (v2u*)(XB + (size_t)m * D) + lane; float sq = 0.f;
#pragma unroll
                    for (int j = 0; j < 8; ++j) { const f32x4 v = xr[64 * j]; v2u w; w.x = pk2(v.x, v.y); w.y = pk2(v.z, v.w); o8[64 * j] = w;
                        sq += (bflo(w.x) * bflo(w.x) + bfhi(w.x) * bfhi(w.x)) + (bflo(w.y) * bflo(w.y) + bfhi(w.y) * bfhi(w.y)); }
                    sq = wave_sum(sq); if (lane < 32) SS[2 * SSP_SLOT + (size_t)m * 32 + lane] = (lane == 0) ? sq : 0.f;
                }
            }
            __syncthreads();
        }
        }
        SEAM(pb + 0);

        if (((PHM >> 1) & 1) && IN(pb + 1)) {
            _Pragma("nounroll") for (int rep_ = 0; rep_ < ((((DBL) >> 1) & 1) ? 2 : 1); ++rep_) {
            {
                PHASE_PTRS();
                pg8::Gemm g{XB, (const bf16*)(W + W_MIXA), D, D, D, M / 256, odd ? C_INP / 256 : AB_IN / 256, 1, 1, 0, 0, 0, 0};
                pg8::Order S; S.init(g, G, cid);
                pg8::Epi<pg8::EP_BF16> E{(void*)BIG, SS + 2 * SSP_SLOT, odd ? C_INP : AB_IN, 256, 0, 0, 0, 0, 1.f, (DBLK) ? rep_ : 0};
                pg8::gemm_phase<pg8::Epi<pg8::EP_BF16>, true>(lds + RING_OFF, g, S, E, 0, lds + XLDS_OFF);
            }
            {
                PHASE_PTRS();
                pg8::Gemm g{(const bf16*)(ws + WS_MEMN), (const bf16*)(W + W_WKV), D, D, D, MMEM / 256, 2 * D / 256, 1, 1, 0, 0, 0, 0};
                pg8::Order S; S.init(g, G, cid);
                pg8::Epi<pg8::EP_BF16> E{(void*)(ws + WS_KVM), nullptr, 2 * D, 256, 0, 0, 0, 0, 1.f, (DBLK) ? rep_ : 0};
                pg8::gemm_phase<pg8::Epi<pg8::EP_BF16>, true>(lds + RING_OFF, g, S, E, 0, lds + XLDS_OFF);
            }
        }
        }
        SEAM(pb + 1);

        if (((PHM >> 2) & 1) && IN(pb + 2)) {
            _Pragma("nounroll") for (int rep_ = 0; rep_ < ((((DBL) >> 2) & 1) ? 2 : 1); ++rep_) {
            if (!odd) {
                PHASE_PTRS();
                const bf16* Z = (const bf16*)BIG; const bf16* WSM = (const bf16*)(ws + WS_WSM);
                const float* vng = INP(9) + (size_t)eo * 1024; const float* bsp = INP(11) + (size_t)eo * 1024; const float* cw = INP(12) + (size_t)eo * 3 * 1024;
                for (int uidx = cid; uidx < 2048; uidx += G) {
                    const int nb = uidx >> 3, gq = uidx & 7; const size_t row0 = (size_t)nb * 128;
                    {
                        const int j = tid >> 2, qd = tid & 3;
                        const v4u* vp = (const v4u*)(Z + (row0 + j) * AB_IN + 1024 + gq * 128 + qd * 32);
                        float vals[32]; float ss = 0.f;
#pragma unroll
                        for (int k4 = 0; k4 < 4; ++k4) { const v4u w = vp[k4]; const unsigned ww[4] = {w.x, w.y, w.z, w.w};
#pragma unroll
                            for (int e = 0; e < 4; ++e) { const float a = gelu_tanh(bflo(ww[e])), b = gelu_tanh(bfhi(ww[e])); vals[k4 * 8 + 2 * e] = a; vals[k4 * 8 + 2 * e + 1] = b; ss += a * a + b * b; } }
                        ss += __shfl_xor(ss, 1); ss += __shfl_xor(ss, 2);
                        const float rinv = 1.0f / sqrtf(ss * (1.0f / 128.0f) + RMS_EPS);
                        const float* gp = vng + gq * 128 + qd * 32;
                        LAS bf16* vt = (LAS bf16*)(lds + RING_OFF);
#pragma unroll
                        for (int k = 0; k < 32; ++k) vt[(qd * 32 + k) * 136 + j] = (bf16)(pk2(vals[k] * rinv * gp[k], 0.f) & 0xffffu);
                    }
                    __syncthreads();
                    {
                        const int r = lane & 15, g4 = lane >> 4; const int irow = 16 * wave + r;
                        bf16x8 wf[4];
#pragma unroll
                        for (int s = 0; s < 4; ++s) wf[s] = *(const bf16x8*)(WSM + ((size_t)(gq * 128 + irow) * 128 + 32 * s + 8 * g4));
                        const float bs = bsp[gq * 128 + irow];
                        const bf16* up = Z + (row0 + irow) * AB_IN + gq * 128 + 4 * g4;
                        bf16* yp = XN + (row0 + irow) * D + gq * 128 + 4 * g4;
#pragma unroll
                        for (int t = 0; t < 8; ++t) {
                            f32x4 acc = (f32x4){0.f, 0.f, 0.f, 0.f};
#pragma unroll
                            for (int s = 0; s < 4; ++s) { const bf16x8 vf = *(const LAS bf16x8*)(lds + RING_OFF + (16 * t + r) * 272 + (32 * s + 8 * g4) * 2);
                                acc = __builtin_amdgcn_mfma_f32_16x16x32_bf16(vf, wf[s], acc, 0, 0, 0); }
                            const v2u uw = *(const v2u*)(up + 16 * t);
                            const float u0 = gelu_tanh(bflo(uw.x)), u1 = gelu_tanh(bfhi(uw.x)), u2 = gelu_tanh(bflo(uw.y)), u3 = gelu_tanh(bfhi(uw.y));
                            v2u o; o.x = pk2(u0 * (acc.x + bs), u1 * (acc.y + bs)); o.y = pk2(u2 * (acc.z + bs), u3 * (acc.w + bs));
                            *(v2u*)(yp + 16 * t) = o;
                        }
                    }
                    __syncthreads();
                }
                for (int i = gtid; i < M * 128; i += GT) {
                    const int row = i >> 7, c8 = (i & 127) * 8, tpos = row & (SEQ - 1);
                    const bf16* zr = Z + (size_t)row * AB_IN;
                    const v4u bg = *(const v4u*)(zr + 2048 + c8);
                    float zc[3][8];
#pragma unroll
                    for (int k = 0; k < 3; ++k) {
                        if (tpos - k >= 0) { const v4u cg = *(const v4u*)(zr - (size_t)k * AB_IN + 3072 + c8), hh = *(const v4u*)(zr - (size_t)k * AB_IN + 4096 + c8);
                            const unsigned cgw[4] = {cg.x, cg.y, cg.z, cg.w}, hw[4] = {hh.x, hh.y, hh.z, hh.w};
#pragma unroll
                            for (int e = 0; e < 4; ++e) { zc[k][2 * e] = bflo(cgw[e]) * bflo(hw[e]); zc[k][2 * e + 1] = bfhi(cgw[e]) * bfhi(hw[e]); } }
                        else {
#pragma unroll
                            for (int e = 0; e < 8; ++e) zc[k][e] = 0.f; }
                    }
                    const unsigned bgw[4] = {bg.x, bg.y, bg.z, bg.w}; float y[8];
#pragma unroll
                    for (int e = 0; e < 8; ++e) { const float bgv = (e & 1) ? bfhi(bgw[e >> 1]) : bflo(bgw[e >> 1]);
                        const float conv = cw[c8 + e] * zc[2][e] + cw[1024 + c8 + e] * zc[1][e] + cw[2048 + c8 + e] * zc[0][e]; y[e] = bgv * conv; }
                    v4u o; o.x = pk2(y[0], y[1]); o.y = pk2(y[2], y[3]); o.z = pk2(y[4], y[5]); o.w = pk2(y[6], y[7]);
                    *(v4u*)(XN + (size_t)row * D + 1024 + c8) = o;
                }
            } else {
                PHASE_PTRS();
                const bf16* LAT = (const bf16*)BIG; bf16* CQN = (bf16*)(BIG + B_CQN); bf16* CKVN = (bf16*)(BIG + B_CKVN); bf16* KR = (bf16*)(BIG + B_KR);
                const float* ROPE = (const float*)(ws + WS_ROPE);
                const float* gqn = INP(15) + (size_t)eo * 512; const float* gkv = INP(16) + (size_t)eo * 256;
                for (int m = gw; m < M; m += NGW) {
                    const bf16* lp = LAT + (size_t)m * C_INP;
                    {
                        const v4u w = *(const v4u*)(lp + 8 * lane); const unsigned ww[4] = {w.x, w.y, w.z, w.w}; float f[8]; float ss = 0.f;
#pragma unroll
                        for (int e = 0; e < 4; ++e) { f[2 * e] = bflo(ww[e]); f[2 * e + 1] = bfhi(ww[e]); ss += f[2 * e] * f[2 * e] + f[2 * e + 1] * f[2 * e + 1]; }
                        const float rr = 1.0f / sqrtf(wave_sum(ss) * (1.0f / 512.0f) + RMS_EPS); const float* gp = gqn + 8 * lane;
                        v4u o; o.x = pk2(f[0] * rr * gp[0], f[1] * rr * gp[1]); o.y = pk2(f[2] * rr * gp[2], f[3] * rr * gp[3]); o.z = pk2(f[4] * rr * gp[4], f[5] * rr * gp[5]); o.w = pk2(f[6] * rr * gp[6], f[7] * rr * gp[7]);
                        *(v4u*)(CQN + (size_t)m * 512 + 8 * lane) = o;
                    }
                    {
                        const int l2 = lane & 31; const v4u w = *(const v4u*)(lp + 512 + 8 * l2); const unsigned ww[4] = {w.x, w.y, w.z, w.w}; float f[8]; float ss = 0.f;
#pragma unroll
                        for (int e = 0; e < 4; ++e) { f[2 * e] = bflo(ww[e]); f[2 * e + 1] = bfhi(ww[e]); ss += f[2 * e] * f[2 * e] + f[2 * e + 1] * f[2 * e + 1]; }
                        if (lane >= 32) ss = 0.f;
                        const float rr = 1.0f / sqrtf(wave_sum(ss) * (1.0f / 256.0f) + RMS_EPS); const float* gp = gkv + 8 * l2;
                        v4u o; o.x = pk2(f[0] * rr * gp[0], f[1] * rr * gp[1]); o.y = pk2(f[2] * rr * gp[2], f[3] * rr * gp[3]); o.z = pk2(f[4] * rr * gp[4], f[5] * rr * gp[5]); o.w = pk2(f[6] * rr * gp[6], f[7] * rr * gp[7]);
                        if (lane < 32) *(v4u*)(CKVN + (size_t)m * 256 + 8 * l2) = o;
                    }
                    if (lane < 4) {
                        const v4u w1 = *(const v4u*)(lp + 768 + 8 * lane), w2 = *(const v4u*)(lp + 800 + 8 * lane);
                        const unsigned a1[4] = {w1.x, w1.y, w1.z, w1.w}, a2[4] = {w2.x, w2.y, w2.z, w2.w};
                        const float* rp = ROPE + (size_t)m * 64 + 8 * lane; float o1[8], o2[8];
#pragma unroll
                        for (int e = 0; e < 8; ++e) { const float xa = (e & 1) ? bfhi(a1[e >> 1]) : bflo(a1[e >> 1]), xb = (e & 1) ? bfhi(a2[e >> 1]) : bflo(a2[e >> 1]);
                            const float cc = rp[e], sn = rp[32 + e]; o1[e] = xa * cc - xb * sn; o2[e] = xb * cc + xa * sn; }
                        v4u q1, q2; q1.x = pk2(o1[0], o1[1]); q1.y = pk2(o1[2], o1[3]); q1.z = pk2(o1[4], o1[5]); q1.w = pk2(o1[6], o1[7]);
                        q2.x = pk2(o2[0], o2[1]); q2.y = pk2(o2[2], o2[3]); q2.z = pk2(o2[4], o2[5]); q2.w = pk2(o2[6], o2[7]);
                        *(v4u*)(KR + (size_t)m * 64 + 8 * lane) = q1; *(v4u*)(KR + (size_t)m * 64 + 32 + 8 * lane) = q2;
                    }
                }
            }
            __syncthreads();
            {
                PHASE_PTRS();
                pg8::Gemm g{(const bf16*)(ws + WS_KVM), (const bf16*)(W + W_WQ), 2 * D, D, 512, MMEM / 256, D / 256, 4, 1, 512, 0, 512, 0};
                pg8::Order S; S.init(g, G, cid);
                pg8::Epi<pg8::EP_BF16> E{(void*)(ws + WS_WQKT), nullptr, D, 1024, 256, 0, 0, 0, 1.f, (DBLK) ? rep_ : 0};
                pg8::gemm_phase<pg8::Epi<pg8::EP_BF16>, true>(lds + RING_OFF, g, S, E, 0, lds + XLDS_OFF);
            }
            {
                PHASE_PTRS();
                pg8::Gemm g{(const bf16*)(W + W_WO), (const bf16*)(ws + WS_KVM) + D, D, 2 * D, 512, D / 256, 1, 4, BATCH, 512, 0, 512, (long)256 * 2 * D};
                pg8::Order S; S.init(g, G, cid);
                pg8::Epi<pg8::EP_BF16> E{(void*)(ws + WS_VWOT), nullptr, 1024, 256, 0, 2048, 256, 0, 1.f, (DBLK) ? rep_ : 0};
                pg8::gemm_phase<pg8::Epi<pg8::EP_BF16>, true>(lds + RING_OFF, g, S, E, 0, lds + XLDS_OFF);
            }
        }
        }
        SEAM(pb + 2);

        if (((PHM >> 3) & 1) && odd && IN(pb + 3)) {
            _Pragma("nounroll") for (int rep_ = 0; rep_ < ((((DBL) >> 3) & 1) ? 2 : 1); ++rep_) {
            {
                PHASE_PTRS();
                pg8::Gemm g{(const bf16*)(BIG + B_CQN), (const bf16*)(W + W_UQ), 512, 512, 512, M / 256, 3072 / 256, 1, 1, 0, 0, 0, 0};
                pg8::Order S; S.init(g, G, cid);
                pg8::Epi<pg8::EP_BF16> E{(void*)(BIG + B_Q), nullptr, 3072, 256, 0, 0, 0, 0, 1.f, (DBLK) ? rep_ : 0};
                pg8::gemm_phase<pg8::Epi<pg8::EP_BF16>, true>(lds + RING_OFF, g, S, E, 0, lds + XLDS_OFF);
            }
            {
                PHASE_PTRS();
                pg8::Gemm g{(const bf16*)(BIG + B_CKVN), (const bf16*)(W + W_UK), 256, 256, 256, M / 256, 2048 / 256, 1, 1, 0, 0, 0, 0};
                pg8::Order S; S.init(g, G, cid);
                pg8::Epi<pg8::EP_BF16> E{(void*)(BIG + B_KN), nullptr, 2048, 256, 0, 0, 0, 0, 1.f, (DBLK) ? rep_ : 0};
                pg8::gemm_phase<pg8::Epi<pg8::EP_BF16>, true>(lds + RING_OFF, g, S, E, 0, lds + XLDS_OFF);
            }
            {
                PHASE_PTRS();
                pg8::Gemm g{(const bf16*)(W + W_UV), (const bf16*)(BIG + B_CKVN), 256, 256, 256, 2048 / 256, SEQ / 256, 1, BATCH, 0, 0, 0, (long)SEQ * 256};
                pg8::Order S; S.init(g, G, cid);
                pg8::Epi<pg8::EP_BF16> E{(void*)(BIG + B_VT), nullptr, 2048, 256, 0, 2048, 0, 0, 1.f, (DBLK) ? rep_ : 0};
                pg8::gemm_phase<pg8::Epi<pg8::EP_BF16>, true>(lds + RING_OFF, g, S, E, 0, lds + XLDS_OFF);
            }
        }
        }
        if (odd) SEAM(pb + 3);

        if (((PHM >> 5) & 1) && odd && IN(pb + 5)) {
            _Pragma("nounroll") for (int rep_ = 0; rep_ < ((((DBL) >> 5) & 1) ? 2 : 1); ++rep_) {
            PHASE_PTRS();
            const att::T t{(const bf16*)(BIG + B_Q), (const bf16*)(BIG + B_KN), (const bf16*)(BIG + B_KR), (const bf16*)(BIG + B_VT), XN, (const float*)(ws + WS_ROPE)};
            for (int idx = cid; idx < 1024; idx += G) {
                const int bh = idx >> 2, p = idx & 3, b = bh >> 4, h = bh & 15;
                att::unit(lds + RING_OFF, t, b, h, p, tid, wave, lane);
                att::unit(lds + RING_OFF, t, b, h, 7 - p, tid, wave, lane);
            }
        }
        }
        if (odd) SEAM(pb + 5);

        if (((PHM >> 6) & 1) && IN(pb + 6)) {
            _Pragma("nounroll") for (int rep_ = 0; rep_ < ((((DBL) >> 6) & 1) ? 2 : 1); ++rep_) {
            PHASE_PTRS();
            pg8::Gemm g{XN, (const bf16*)(W + W_MIXB), D, D, D, M / 256, D / 256, 1, 1, 0, 0, 0, 0};
            pg8::Order S; S.init(g, G, cid);
            pg8::Epi<pg8::EP_RESID> E{(void*)XB, SS + 0 * SSP_SLOT, D, 256, 0, 0, 0, 0, rep_ ? 0.f : 1.f, (DBLK) ? rep_ : 0};
            pg8::gemm_phase<pg8::Epi<pg8::EP_RESID>, true>(lds + RING_OFF, g, S, E, 0, lds + XLDS_OFF);
        }
        }
        SEAM(pb + 6);

        if (((PHM >> 8) & 1) && IN(pb + 8)) {
            _Pragma("nounroll") for (int rep_ = 0; rep_ < ((((DBL) >> 8) & 1) ? 2 : 1); ++rep_) {
            PHASE_PTRS();
            pg8::Gemm g{XB, (const bf16*)(ws + WS_WQKT), D, D, D, SEQ / 256, 1024 / 256, 1, BATCH, 0, (long)SEQ * D, 0, (long)1024 * D};
            pg8::Order S; S.init(g, G, cid);
            pg8::Epi<pg8::EP_SOFTMAX> E{(void*)(BIG + B_P), SS + 0 * SSP_SLOT, 1024, 256, 0, SEQ, 0, 0, 0.04419417382415922f, (DBLK) ? rep_ : 0};
            pg8::gemm_phase<pg8::Epi<pg8::EP_SOFTMAX>, true>(lds + RING_OFF, g, S, E, 0, lds + XLDS_OFF);
        }
        }
        SEAM(pb + 8);

        if (((PHM >> 10) & 1) && IN(pb + 10)) {
            _Pragma("nounroll") for (int rep_ = 0; rep_ < ((((DBL) >> 10) & 1) ? 2 : 1); ++rep_) {
            PHASE_PTRS();
            pg8::Gemm g{(const bf16*)(BIG + B_P), (const bf16*)(ws + WS_VWOT), 1024, 1024, 1024, SEQ / 256, D / 256, 1, BATCH, 0, (long)SEQ * 1024, 0, (long)D * 1024};
            pg8::Order S; S.init(g, G, cid);
            pg8::Epi<pg8::EP_RESID> E{(void*)XB, SS + 1 * SSP_SLOT, D, 256, 0, SEQ, 0, 0, rep_ ? 0.f : 1.f, (DBLK) ? rep_ : 0};
            pg8::gemm_phase<pg8::Epi<pg8::EP_RESID>, true>(lds + RING_OFF, g, S, E, 0, lds + XLDS_OFF);
        }
        }
        SEAM(pb + 10);

        if (((PHM >> 12) & 1) && IN(pb + 12)) {
            _Pragma("nounroll") for (int rep_ = 0; rep_ < ((((DBL) >> 12) & 1) ? 2 : 1); ++rep_) {
            PHASE_PTRS();
            pg8::Gemm g{XB, (const bf16*)(W + W_W1), D, D, D, M / 256, DFF / 256, 1, 1, 0, 0, 0, 0};
            pg8::Order S; S.init(g, G, cid);
            pg8::Epi<pg8::EP_RELU2> E{(void*)BIG, SS + 1 * SSP_SLOT, DFF, 256, 0, 0, 0, 0, 1.f, (DBLK) ? rep_ : 0};
            pg8::gemm_phase<pg8::Epi<pg8::EP_RELU2>, true>(lds + RING_OFF, g, S, E, ((cid >> 3) & 3) * STAG_FFN1, lds + XLDS_OFF);
        }
        }
        SEAM(pb + 12);

        if (((PHM >> 13) & 1) && IN(pb + 13)) {
            _Pragma("nounroll") for (int rep_ = 0; rep_ < ((((DBL) >> 13) & 1) ? 2 : 1); ++rep_) {
            PHASE_PTRS();
            pg8::Gemm g{(const bf16*)BIG, (const bf16*)(W + W_W2), DFF, DFF, DFF, M / 256, D / 256, 1, 1, 0, 0, 0, 0};
            pg8::Order S; S.init(g, G, cid);
            pg8::Epi<pg8::EP_RESID> E{(void*)XB, SS + 2 * SSP_SLOT, D, 256, 0, 0, 0, 0, rep_ ? 0.f : 1.f, (DBLK) ? rep_ : 0};
            pg8::gemm_phase<pg8::Epi<pg8::EP_RESID>, true>(lds + RING_OFF, g, S, E, 0, lds + XLDS_OFF);
        }
        }
        if (IN(pb + 13) && IN(pb + PH_PER_LAYER)) GRID_BAR();
    }

    if (((PHM >> 16) & 1) && IN(PH_FINAL)) {
        PHASE_PTRS();
        const float* gain = INP(7); float* OUT = (float*)ldptr(lds, 26); const float* ssl = SS + 2 * SSP_SLOT;
        for (int m = gw; m < M; m += NGW) {
            const float r = __builtin_amdgcn_rsqf(wave_sum(lane < 32 ? ssl[(size_t)m * 32 + lane] : 0.f) * (1.0f / D) + RMS_EPS);
            const v4u* xr = (const v4u*)(XB + (size_t)m * D) + lane; f32x4* orow = (f32x4*)(OUT + (size_t)m * D);
#pragma unroll
            for (int j = 0; j < 4; ++j) { const v4u w = xr[64 * j]; const int c = 8 * (lane + 64 * j);
                const f32x4 g0 = *(const f32x4*)(gain + c), g1 = *(const f32x4*)(gain + c + 4);
                orow[(c >> 2)] = (f32x4){bflo(w.x) * r * g0.x, bfhi(w.x) * r * g0.y, bflo(w.y) * r * g0.z, bfhi(w.y) * r * g0.w};
                orow[(c >> 2) + 1] = (f32x4){bflo(w.z) * r * g1.x, bfhi(w.z) * r * g1.y, bflo(w.w) * r * g1.z, bfhi(w.w) * r * g1.w}; }
        }
    }
#undef IN
#undef BOTH
#undef SEAM
}

extern "C" void kernel_launch(void* const* d_in, const int* in_sizes, int n_in, void* d_out, int out_size, void* d_ws, size_t ws_size, hipStream_t stream) {
    static int grid = 0;
    if (grid == 0) {
        if (n_in != 26 || out_size != M * D || ws_size < WS_END) { fprintf(stderr, "kernel_launch: unexpected problem (n_in %d, out %d, ws %zu)\n", n_in, out_size, ws_size); grid = -1; return; }
        int dev = 0, cus = 0, per_cu = 0;
        if (hipGetDevice(&dev) != hipSuccess || hipDeviceGetAttribute(&cus, hipDeviceAttributeMultiprocessorCount, dev) != hipSuccess) { grid = -1; return; }
        if (hipFuncSetAttribute((const void*)trunk_fwd, hipFuncAttributeMaxDynamicSharedMemorySize, LDS_BYTES) != hipSuccess) { fprintf(stderr, "kernel_launch: hipFuncSetAttribute failed\n"); grid = -1; return; }
        if (hipOccupancyMaxActiveBlocksPerMultiprocessor(&per_cu, (const void*)trunk_fwd, NWAVES * 64, LDS_BYTES) != hipSuccess || per_cu < 1) { fprintf(stderr, "kernel_launch: occupancy query says %d\n", per_cu); }
        (void)hipGetLastError();
        grid = cus;
    }
    if (grid < 0) return;
    if (hipMemsetAsync((char*)d_ws + WS_CTL, 0, CTL_ZERO_BYTES, stream) != hipSuccess) return;
    Args a{};
    for (int i = 0; i < 26; ++i) a.in[i] = (const float*)d_in[i];
    a.out = (float*)d_out; a.ws = (unsigned char*)d_ws;
    for (int i = 0; i < 32; ++i) a.inv_freq[i] = (float)pow(10000.0, -(double)(2 * i) / 64.0);
#if MK_PER_PHASE
    for (int p = 0; p < PH_TOTAL; ++p) {
        const int k = p % PH_PER_LAYER, layer = p / PH_PER_LAYER;
        if (p < PH_FINAL) { if (k == 4 || k == 7 || k == 9 || k == 11 || k > 13) continue; if (!(layer & 1) && (k == 3 || k == 5)) continue; }
        a.ph_lo = p; a.ph_hi = p + 1;
        hipLaunchKernelGGL(trunk_fwd, dim3(grid), dim3(NWAVES * 64), LDS_BYTES, stream, a);
    }
#else
    a.ph_lo = 0; a.ph_hi = PH_TOTAL;
    hipLaunchKernelGGL(trunk_fwd, dim3(grid), dim3(NWAVES * 64), LDS_BYTES, stream, a);
#endif
}
```
